# Optimizing an MI355X kernel written in HIP

```python
import jax, jax.numpy as jnp
from jax import lax
import numpy as np

D_MODEL = 1024
BATCH = 4
SEQ = 4096
DEPTH = 4

CHUNK = 64
Q_BLOCK = 128
HEAD_DIM = 64
N_DIFF_HEADS = D_MODEL // 4 // HEAD_DIM
N_FOX_HEADS = D_MODEL // 2 // HEAD_DIM
DIFF_WIDTH = N_DIFF_HEADS * 2 * HEAD_DIM
FOX_WIDTH = N_FOX_HEADS * HEAD_DIM
MIX_WIDTH = DIFF_WIDTH + FOX_WIDTH
IN_COLS = 3 * DIFF_WIDTH + 3 * FOX_WIDTH + N_FOX_HEADS
ROT_DIM = HEAD_DIM // 4
ROPE_THETA = 500000.0
N_GROUPS = 4
EXPERTS_PER_GROUP = 8
N_EXPERTS = N_GROUPS * EXPERTS_PER_GROUP
TOP_K = 2
D_EXPERT = D_MODEL // 2
EXPERT_BLOCK = 128
EPS = 1e-6

kernel_name = "hybrid_diff_fox_hmoe_adaln"


def rms_norm(x, g):
    xf = x.astype(jnp.float32)
    y = xf * lax.rsqrt(jnp.mean(xf * xf, axis=-1, keepdims=True) + EPS)
    return (y * g.astype(jnp.float32)).astype(x.dtype)


def rope_tables(positions):
    inv = ROPE_THETA ** (-jnp.arange(0, ROT_DIM, 2, dtype=jnp.float32) / ROT_DIM)
    ang = positions.astype(jnp.float32)[..., None] * inv
    return jnp.cos(ang), jnp.sin(ang)


def partial_rope(x, cos, sin):
    half = ROT_DIM // 2
    cos = cos.astype(x.dtype)
    sin = sin.astype(x.dtype)
    x1 = x[..., :half]
    x2 = x[..., half:ROT_DIM]
    return jnp.concatenate([x1 * cos - x2 * sin, x2 * cos + x1 * sin, x[..., ROT_DIM:]], axis=-1)


def diff_attention(q, k, v, lam):
    B, S, H = q.shape[:3]
    nb = S // Q_BLOCK
    scale = HEAD_DIM ** -0.5
    kf = k.astype(jnp.float32)
    vf = v.astype(jnp.float32)
    qb = q.reshape(B, nb, Q_BLOCK, H, 2, HEAD_DIM).transpose(1, 0, 2, 3, 4, 5)
    key_chunk = jnp.arange(S) // CHUNK

    def block(args):
        qi, bi = args
        s = jnp.einsum('bqhcd,bkhcd->bhcqk', qi.astype(jnp.float32), kf) * scale
        q_chunk = (bi * Q_BLOCK + jnp.arange(Q_BLOCK)) // CHUNK
        mask = key_chunk[None, :] <= q_chunk[:, None]
        p = jax.nn.softmax(jnp.where(mask, s, -jnp.inf), axis=-1)
        a = p[:, :, 0] - lam * p[:, :, 1]
        return jnp.einsum('bhqk,bkhe->bqhe', a, vf)

    o = lax.map(block, (qb, jnp.arange(nb)))
    return o.transpose(1, 0, 2, 3, 4).reshape(B, S, H, 2 * HEAD_DIM).astype(v.dtype)


def forgetting_attention(q, k, v, log_f):
    B, S, H = q.shape[:3]
    nb = S // Q_BLOCK
    scale = HEAD_DIM ** -0.5
    cf = jnp.cumsum(log_f, axis=1)
    cf_k = cf.transpose(0, 2, 1)
    kf = k.astype(jnp.float32)
    vf = v.astype(jnp.float32)
    qb = q.reshape(B, nb, Q_BLOCK, H, HEAD_DIM).transpose(1, 0, 2, 3, 4)
    cqb = cf.reshape(B, nb, Q_BLOCK, H).transpose(1, 0, 3, 2)
    key_idx = jnp.arange(S)

    def block(args):
        qi, cq, bi = args
        s = jnp.einsum('bqhd,bkhd->bhqk', qi.astype(jnp.float32), kf) * scale
        s = s + (cq[..., :, None] - cf_k[:, :, None, :])
        t = bi * Q_BLOCK + jnp.arange(Q_BLOCK)
        mask = key_idx[None, :] <= t[:, None]
        p = jax.nn.softmax(jnp.where(mask, s, -jnp.inf), axis=-1)
        return jnp.einsum('bhqk,bkhd->bqhd', p, vf)

    o = lax.map(block, (qb, cqb, jnp.arange(nb)))
    return o.transpose(1, 0, 2, 3, 4).reshape(B, S, H, HEAD_DIM).astype(v.dtype)


def token_mixer(h, cos, sin, layer, w_in_l, b_forget_l, lq1, lk1, lq2, lk2, g_subln_l, g_fox_l, w_out_l):
    B, S, _ = h.shape
    proj = h @ w_in_l
    cuts = [DIFF_WIDTH, 2 * DIFF_WIDTH, 3 * DIFF_WIDTH,
            3 * DIFF_WIDTH + FOX_WIDTH, 3 * DIFF_WIDTH + 2 * FOX_WIDTH, 3 * DIFF_WIDTH + 3 * FOX_WIDTH]
    dq, dk, dv, fq, fk, fv, ff = jnp.split(proj, cuts, axis=-1)

    rc, rs = cos[:, :, None, None, :], sin[:, :, None, None, :]
    dq = partial_rope(dq.reshape(B, S, N_DIFF_HEADS, 2, HEAD_DIM), rc, rs)
    dk = partial_rope(dk.reshape(B, S, N_DIFF_HEADS, 2, HEAD_DIM), rc, rs)
    dv = dv.reshape(B, S, N_DIFF_HEADS, 2 * HEAD_DIM)
    lambda_init = 0.8 - 0.6 * float(np.exp(-0.3 * layer))
    lam = (jnp.exp(jnp.sum(lq1.astype(jnp.float32) * lk1.astype(jnp.float32)))
           - jnp.exp(jnp.sum(lq2.astype(jnp.float32) * lk2.astype(jnp.float32))) + lambda_init)
    o_diff = diff_attention(dq, dk, dv, lam)
    o_diff = (rms_norm(o_diff, g_subln_l) * (1.0 - lambda_init)).reshape(B, S, DIFF_WIDTH)

    fq = fq.reshape(B, S, N_FOX_HEADS, HEAD_DIM)
    fk = fk.reshape(B, S, N_FOX_HEADS, HEAD_DIM)
    fv = fv.reshape(B, S, N_FOX_HEADS, HEAD_DIM)
    log_f = jax.nn.log_sigmoid(ff.astype(jnp.float32) + b_forget_l.astype(jnp.float32))
    o_fox = forgetting_attention(fq, fk, fv, log_f)
    o_fox = rms_norm(o_fox, g_fox_l).reshape(B, S, FOX_WIDTH)

    return jnp.concatenate([o_diff, o_fox], axis=-1) @ w_out_l


def hierarchical_moe(h, wg, bg, we, be, w_gate, w_up, w_down):
    B, S, D = h.shape
    N = B * S
    hf = h.reshape(N, D)
    hr = hf.astype(jnp.float32)
    p_group = jax.nn.softmax(hr @ wg.astype(jnp.float32) + bg.astype(jnp.float32), axis=-1)
    g_sel = jnp.argmax(p_group, axis=-1)
    p_g = jnp.take_along_axis(p_group, g_sel[:, None], axis=-1)
    logits_e = (hr @ we.astype(jnp.float32) + be.astype(jnp.float32)).reshape(N, N_GROUPS, EXPERTS_PER_GROUP)
    logits_sel = jnp.take_along_axis(logits_e, g_sel[:, None, None], axis=1)[:, 0]
    top_l, top_i = lax.top_k(logits_sel, TOP_K)
    weights = p_g * jax.nn.softmax(top_l, axis=-1)
    expert_id = g_sel[:, None] * EXPERTS_PER_GROUP + top_i

    A = N * TOP_K
    e_flat = expert_id.reshape(A).astype(jnp.int32)
    tok_flat = jnp.repeat(jnp.arange(N, dtype=jnp.int32), TOP_K)
    w_flat = weights.reshape(A)
    order = jnp.argsort(e_flat)
    e_sorted = e_flat[order]
    counts = jax.ops.segment_sum(jnp.ones((A,), jnp.int32), e_flat, num_segments=N_EXPERTS)
    padded = ((counts + EXPERT_BLOCK - 1) // EXPERT_BLOCK) * EXPERT_BLOCK
    start = jnp.cumsum(counts) - counts
    pend = jnp.cumsum(padded)
    pstart = pend - padded
    dest = pstart[e_sorted] + (jnp.arange(A, dtype=jnp.int32) - start[e_sorted])
    P = A + N_EXPERTS * EXPERT_BLOCK
    n_blocks = P // EXPERT_BLOCK
    slot_tok = jnp.zeros((P,), jnp.int32).at[dest].set(tok_flat[order])
    slot_w = jnp.zeros((P,), jnp.float32).at[dest].set(w_flat[order])
    block_expert = jnp.minimum(
        jnp.searchsorted(pend, jnp.arange(n_blocks, dtype=jnp.int32) * EXPERT_BLOCK, side='right'),
        N_EXPERTS - 1)
    xs = hf[slot_tok].reshape(n_blocks, EXPERT_BLOCK, D)

    def run_block(args):
        xb, e = args
        return (jax.nn.silu(xb @ w_gate[e]) * (xb @ w_up[e])) @ w_down[e]

    ys = lax.map(run_block, (xs, block_expert)).reshape(P, D)
    out = jnp.zeros((N, D), ys.dtype).at[slot_tok].add(ys * slot_w[:, None].astype(ys.dtype))
    return out.reshape(B, S, D)


def setup_inputs(seed: int = 0) -> dict:
    key = jax.random.key(seed)
    ks = jax.random.split(key, 26)
    D = D_MODEL

    def nrm(k, shape, fan_in, mult=1.0):
        return jax.random.normal(k, shape, jnp.float32) * (mult * fan_in ** -0.5)

    def gain(k, shape):
        return 1.0 + 0.02 * jax.random.normal(k, shape, jnp.float32)

    offsets = jax.random.randint(ks[2], (BATCH, 1), 0, 4096)
    positions = (offsets + jnp.arange(SEQ)[None, :]).astype(jnp.int32)
    return {
        "x": jax.random.normal(ks[0], (BATCH, SEQ, D), jnp.float32),
        "c": jax.random.normal(ks[1], (BATCH, D), jnp.float32),
        "positions": positions,
        "w_ada": nrm(ks[3], (DEPTH, D, 6 * D), D, 0.5),
        "b_ada": 0.02 * jax.random.normal(ks[4], (DEPTH, 6 * D), jnp.float32),
        "g_mix": gain(ks[5], (DEPTH, D)),
        "w_in": nrm(ks[6], (DEPTH, D, IN_COLS), D),
        "b_forget": 1.0 + 4.0 * jax.random.uniform(ks[7], (DEPTH, N_FOX_HEADS), jnp.float32),
        "lambda_q1": 0.1 * jax.random.normal(ks[8], (DEPTH, HEAD_DIM), jnp.float32),
        "lambda_k1": 0.1 * jax.random.normal(ks[9], (DEPTH, HEAD_DIM), jnp.float32),
        "lambda_q2": 0.1 * jax.random.normal(ks[10], (DEPTH, HEAD_DIM), jnp.float32),
        "lambda_k2": 0.1 * jax.random.normal(ks[11], (DEPTH, HEAD_DIM), jnp.float32),
        "g_subln": gain(ks[12], (DEPTH, 2 * HEAD_DIM)),
        "g_fox_out": gain(ks[13], (DEPTH, HEAD_DIM)),
        "w_out": nrm(ks[14], (DEPTH, MIX_WIDTH, D), MIX_WIDTH),
        "g_ffn": gain(ks[15], (DEPTH, D)),
        "w_router_group": nrm(ks[16], (DEPTH, D, N_GROUPS), D),
        "b_router_group": 0.01 * jax.random.normal(ks[17], (DEPTH, N_GROUPS), jnp.float32),
        "w_router_expert": nrm(ks[18], (DEPTH, D, N_EXPERTS), D),
        "b_router_expert": 0.01 * jax.random.normal(ks[19], (DEPTH, N_EXPERTS), jnp.float32),
        "w_expert_gate": nrm(ks[20], (DEPTH, N_EXPERTS, D, D_EXPERT), D),
        "w_expert_up": nrm(ks[21], (DEPTH, N_EXPERTS, D, D_EXPERT), D),
        "w_expert_down": nrm(ks[22], (DEPTH, N_EXPERTS, D_EXPERT, D), D_EXPERT),
        "g_final": gain(ks[23], (D,)),
    }


def reference(x, c, positions, w_ada, b_ada, g_mix, w_in, b_forget, lambda_q1, lambda_k1,
              lambda_q2, lambda_k2, g_subln, g_fox_out, w_out, g_ffn, w_router_group,
              b_router_group, w_router_expert, b_router_expert, w_expert_gate, w_expert_up,
              w_expert_down, g_final):
    cond = jax.nn.silu(c)
    cos, sin = rope_tables(positions)
    for l in range(DEPTH):
        mod = (cond @ w_ada[l] + b_ada[l])[:, None, :]
        sh1, sc1, gt1, sh2, sc2, gt2 = jnp.split(mod, 6, axis=-1)
        h = rms_norm(x, g_mix[l]) * (1.0 + sc1) + sh1
        mix = token_mixer(h, cos, sin, l, w_in[l], b_forget[l], lambda_q1[l], lambda_k1[l],
                          lambda_q2[l], lambda_k2[l], g_subln[l], g_fox_out[l], w_out[l])
        x = x + gt1 * mix
        h = rms_norm(x, g_ffn[l]) * (1.0 + sc2) + sh2
        moe = hierarchical_moe(h, w_router_group[l], b_router_group[l], w_router_expert[l],
                               b_router_expert[l], w_expert_gate[l], w_expert_up[l], w_expert_down[l])
        x = x + gt2 * moe
    return rms_norm(x, g_final)
```

```cpp
#include <hip/hip_runtime.h>
#include <cstdio>
#include <cstdint>

#ifndef MK_PER_PHASE
#define MK_PER_PHASE 0
#endif

#define GAS __attribute__((address_space(1)))
#define LAS __attribute__((address_space(3)))
typedef unsigned short bf16_t;
typedef short bf16x8 __attribute__((ext_vector_type(8)));
typedef short s16x4 __attribute__((ext_vector_type(4)));
typedef float f32x4 __attribute__((ext_vector_type(4)));
typedef float f32x2 __attribute__((ext_vector_type(2)));
typedef float f32x16 __attribute__((ext_vector_type(16)));
typedef unsigned u32x4 __attribute__((ext_vector_type(4)));
typedef unsigned u32x2 __attribute__((ext_vector_type(2)));
typedef GAS unsigned gu32;

constexpr int DM = 1024, NB_ = 4, SEQ = 4096, DEPTH = 4, NTOK = NB_ * SEQ;
constexpr int INC = 3080, NQKV = 3072;
constexpr int NEXP = 32, DEXP = 512;
constexpr float EPS = 1e-6f;
constexpr float C2 = 0.125f * 1.4426950408889634f;
constexpr float LOG2E = 1.4426950408889634f;
constexpr int NPH_LAYER = 7, NPHASES = 2 + NPH_LAYER * DEPTH;

constexpr size_t MiB = 1u << 20;
constexpr size_t WS_CTL = 0, CTL_ZERO_BYTES = 1 * MiB;
constexpr size_t WS_MOD = 1 * MiB;
constexpr size_t WS_ROPE = 2 * MiB;
constexpr size_t WS_WINF = 3 * MiB;
constexpr size_t WS_WRT = 4 * MiB;
constexpr size_t WS_LF = 5 * MiB;
constexpr size_t WS_CF = 6 * MiB;
constexpr size_t WS_LIST = 8 * MiB;
constexpr size_t WS_WLIST = 10 * MiB;
constexpr size_t WS_WIN = 16 * MiB;
constexpr size_t WS_WOUT = 40 * MiB;
constexpr size_t WS_WGU = 48 * MiB;
constexpr size_t WS_WD = 304 * MiB;
constexpr size_t WS_H = 432 * MiB;
constexpr size_t WS_QKV = 464 * MiB;
constexpr size_t WS_ATT = 560 * MiB;
constexpr size_t WS_ACT = 592 * MiB;
constexpr size_t WS_YS = 632 * MiB;
constexpr size_t WS_X = 696 * MiB;
constexpr size_t WS_END = 728 * MiB;
constexpr int CW_BAR = 4096;
constexpr int CW_CNT = 16384;

constexpr int RING_BYTES = 131072;
constexpr int TAB_OFF = RING_BYTES;
constexpr int RBT_OFF = TAB_OFF + 16384;
constexpr int MISC_OFF = RBT_OFF + 2048;
constexpr int TENT_OFF = MISC_OFF + 512;
constexpr int LDS_BYTES = TENT_OFF + 8192;

#define RLX_AGENT __ATOMIC_RELAXED, __HIP_MEMORY_SCOPE_AGENT
#define LDS_WAIT() asm volatile("s_waitcnt lgkmcnt(0)" ::: "memory")
#define VM_WAIT() asm volatile("s_waitcnt vmcnt(0)" ::: "memory")
__device__ __forceinline__ unsigned f2bf(float f) { unsigned u = __builtin_bit_cast(unsigned, f); return (u + 0x7fffu + ((u >> 16) & 1u)) >> 16; }
__device__ __forceinline__ unsigned pk2(float lo, float hi) { return f2bf(lo) | (f2bf(hi) << 16); }
__device__ __forceinline__ float bflo(unsigned u) { return __builtin_bit_cast(float, u << 16); }
__device__ __forceinline__ float bfhi(unsigned u) { return __builtin_bit_cast(float, u & 0xffff0000u); }
typedef __bf16 bf16x2_t __attribute__((ext_vector_type(2)));
__device__ __forceinline__ unsigned cvtpk(float lo, float hi) { f32x2 v = {lo, hi}; bf16x2_t b = __builtin_convertvector(v, bf16x2_t); return __builtin_bit_cast(unsigned, b); }
template <int CTRL> __device__ __forceinline__ float dpp_f(float v) { return __builtin_bit_cast(float, __builtin_amdgcn_update_dpp(0, __builtin_bit_cast(int, v), CTRL, 0xF, 0xF, true)); }
__device__ __forceinline__ float xor16_f(float v) { return __builtin_bit_cast(float, __builtin_amdgcn_ds_swizzle(__builtin_bit_cast(int, v), 0x401F)); }
__device__ __forceinline__ float swap32_f(float v) { return __shfl_xor(v, 32); }
__device__ __forceinline__ float sum32_f(float v) { return v + swap32_f(v); }
__device__ __forceinline__ float max32_f(float v) { return fmaxf(v, swap32_f(v)); }
__device__ __forceinline__ float wave_sum(float v) {
    v += dpp_f<0xB1>(v);
    v += dpp_f<0x4E>(v);
    v += dpp_f<0x141>(v);
    v += dpp_f<0x140>(v);
    v += __builtin_bit_cast(float, __builtin_amdgcn_update_dpp(0, __builtin_bit_cast(int, v), 0x142, 0xA, 0xF, false));
    v += __builtin_bit_cast(float, __builtin_amdgcn_update_dpp(0, __builtin_bit_cast(int, v), 0x143, 0xC, 0xF, false));
    return __builtin_bit_cast(float, __builtin_amdgcn_readlane(__builtin_bit_cast(int, v), 63));
}
__device__ __forceinline__ int otid() { int t = threadIdx.x; asm volatile("" : "+v"(t)); return t; }
__device__ __forceinline__ unsigned ld_agent(const unsigned* p) { return __hip_atomic_load(p, __ATOMIC_RELAXED, __HIP_MEMORY_SCOPE_AGENT); }

#define XB_TMO      128
#define XB_XCNT(j)  (256  + 64 * (j))
#define XB_XSUB(j)  (1280 + 64 * (j))
#define XB_XGEN(j)  (2304 + 64 * (j))
#define XB_TOP      3328
#define XB_TOPGEN   3392
#define XCD_BAR_WORDS 3456
#define XB_SPIN_CAP (1u << 18)
__device__ __forceinline__ unsigned xb_ld(unsigned* p)              { return __hip_atomic_load(p, __ATOMIC_RELAXED, __HIP_MEMORY_SCOPE_AGENT); }
__device__ __forceinline__ unsigned xb_add(unsigned* p, unsigned v) { return __hip_atomic_fetch_add(p, v, __ATOMIC_RELAXED, __HIP_MEMORY_SCOPE_AGENT); }
__device__ __forceinline__ unsigned xb_xcc_id() { return (unsigned)__builtin_amdgcn_s_getreg((3 << 11) | 20) & 0xFu; }
#define XB_SPIN(cond, bar) do { unsigned _sp = 0; while (cond) { __builtin_amdgcn_s_sleep(1); \
    if ((++_sp & 255u) == 0u) { if (xb_ld(&(bar)[XB_TMO])) break; if (_sp > XB_SPIN_CAP) { atomicAdd(&(bar)[XB_TMO], 1u); break; } } } } while (0)
struct XcdBarrier { unsigned* bar; unsigned x; volatile LAS unsigned* st; };
__device__ __forceinline__ XcdBarrier xcd_barrier_post(unsigned* bar, volatile LAS unsigned* st) {
    XcdBarrier b; b.bar = bar; b.x = xb_xcc_id(); b.st = st;
    if (threadIdx.x == 0) (void)xb_add(&bar[XB_XCNT(b.x)], 1u);
    return b;
}
__device__ __forceinline__ void xcd_barrier_complete(unsigned* bar, unsigned x, unsigned& nloc, unsigned& nx) {
    const unsigned G = gridDim.x * gridDim.y * gridDim.z;
    unsigned sum, cnt, mine, sp = 0u;
    for (;;) {
        sum = 0u; cnt = 0u; mine = 0u;
#pragma unroll
        for (unsigned j = 0; j < 16; ++j) { const unsigned c = xb_ld(&bar[XB_XCNT(j)]); sum += c; cnt += (c > 0u) ? 1u : 0u; mine = (j == x) ? c : mine; }
        if (sum == G) break;
        __builtin_amdgcn_s_sleep(1);
        if ((++sp & 255u) == 0u) { if (xb_ld(&bar[XB_TMO])) break; if (sp > XB_SPIN_CAP) { atomicAdd(&bar[XB_TMO], 1u); break; } }
    }
    nloc = mine > 0u ? mine : 1u; nx = cnt > 0u ? cnt : 1u;
}
__device__ __forceinline__ void xcd_barrier(const XcdBarrier& b) {
    asm volatile("s_waitcnt vmcnt(0)" ::: "memory");
    __syncthreads();
    if (threadIdx.x == 0) {
        unsigned* bar = b.bar;
        __builtin_amdgcn_s_waitcnt(0);
        unsigned nloc = b.st[0], nx = b.st[1];
        if (nloc == 0u) { xcd_barrier_complete(bar, b.x, nloc, nx); b.st[0] = nloc; b.st[1] = nx; }
        const unsigned old = xb_add(&bar[XB_XSUB(b.x)], 1u);
        const unsigned gen = old / nloc;
        if (old + 1u == (gen + 1u) * nloc) {
            __builtin_amdgcn_fence(__ATOMIC_RELEASE, "agent");
            asm volatile("s_waitcnt vmcnt(0)" ::: "memory");
            const unsigned og = xb_add(&bar[XB_TOP], 1u);
            const unsigned tg = og / nx;
            if (og + 1u == (tg + 1u) * nx) xb_add(&bar[XB_TOPGEN], 1u);
            else XB_SPIN(xb_ld(&bar[XB_TOPGEN]) == tg, bar);
            __builtin_amdgcn_fence(__ATOMIC_ACQUIRE, "agent");
            xb_add(&bar[XB_XGEN(b.x)], 1u);
            asm volatile("s_waitcnt vmcnt(0)" ::: "memory");
        } else {
            XB_SPIN(xb_ld(&bar[XB_XGEN(b.x)]) == gen, bar);
            __builtin_amdgcn_fence(__ATOMIC_ACQUIRE, "agent");
            asm volatile("s_waitcnt vmcnt(0)" ::: "memory");
        }
    }
    __syncthreads();
}

namespace pg8 {
constexpr int BM = 256, BK = 64, HALF = 128, HTB = HALF * BK * 2, STAGE_BYTES = 8 * HTB, NXCD = 8, WGM = 8;
__host__ __device__ __forceinline__ int lds_byte(int r, int c) { const int st = (r >> 4) * 2 + (c >> 5), rr = r & 15, cc = c & 31, ob = rr * 64 + cc * 2; return st * 1024 + (ob ^ (((ob >> 9) & 1) << 5)); }
__host__ __device__ __forceinline__ void stage_rc(int b, int& R, int& C) { const int st = b / 1024, sb = b % 1024, swz = sb ^ (((sb >> 9) & 1) << 5); R = (st >> 1) * 16 + swz / 64; C = (st & 1) * 32 + (swz % 64) / 2; }
__host__ __device__ __forceinline__ int perm32(int rho) { const int n = rho >> 4, i = rho & 15; return 8 * (i >> 2) + 4 * n + (i & 3); }

struct Unit { int pm, pn, e, slot; };

template <class Epi, class Sched, bool ALIGN_EPI = true>
__device__ __forceinline__ void gemm_phase(LAS unsigned char* lds, const char* Abase, const int K, const Sched& S, const Epi& E) {
    constexpr bool GATHER = Sched::GATHER;
    const int tid_ = otid();
    const int tid = tid_, wid = __builtin_amdgcn_readfirstlane(tid >> 6), lane = tid & 63, wr = wid >> 2, wc = wid & 3, fr = lane & 15, fq = lane >> 4;
    const int nt = K / BK;
    int Ri[2]; unsigned Ci2[2], voffA[2], voffB[2];
#pragma unroll
    for (int i = 0; i < 2; ++i) { int R, C; stage_rc(tid * 16 + i * 8192, R, C); const int Rb = (R & ~31) + perm32(R & 31);
        Ri[i] = R; Ci2[i] = (unsigned)C * 2u; voffA[i] = (unsigned)(R * K + C) * 2u; voffB[i] = (unsigned)(Rb * K + C) * 2u; }
    const size_t kstep = (size_t)(BK * 2);
    const size_t hstep = (size_t)HALF * K * 2;
    const unsigned ldsw = (unsigned)wid * 1024u;
    const int aoff = lds_byte(wr * 64 + fr, fq * 8), boff = lds_byte(wc * 32 + fr, fq * 8);
#define PG8_SA(b, h) (((b) * 2 + (h)) * HTB)
#define PG8_SB(b, h) ((4 + (b) * 2 + (h)) * HTB)
#define PG8_STAGE_B(bufoff, gbase) do { _Pragma("unroll") for (int _i = 0; _i < 2; ++_i) \
        __builtin_amdgcn_global_load_lds((const unsigned*)((const char*)(gbase) + voffB[_i]), (LAS unsigned*)(lds + (bufoff) + ldsw + _i * 8192), 16, 0, 0); } while (0)
#define PG8_STAGE_A(bufoff, uptr, us, h, koff) do { if constexpr (GATHER) { _Pragma("unroll") for (int _i = 0; _i < 2; ++_i) { const unsigned _vo = S.toff[(us) * 256 + (h) * HALF + Ri[_i]] + Ci2[_i]; \
            __builtin_amdgcn_global_load_lds((const unsigned*)(Abase + (koff) + _vo), (LAS unsigned*)(lds + (bufoff) + ldsw + _i * 8192), 16, 0, 0); } } \
        else { _Pragma("unroll") for (int _i = 0; _i < 2; ++_i) \
            __builtin_amdgcn_global_load_lds((const unsigned*)((uptr) + (size_t)(h) * hstep + (koff) + voffA[_i]), (LAS unsigned*)(lds + (bufoff) + ldsw + _i * 8192), 16, 0, 0); } } while (0)
#define PG8_LDA(dst, b, h) do { _Pragma("unroll") for (int m = 0; m < 4; ++m) _Pragma("unroll") for (int k = 0; k < 2; ++k) dst[m][k] = *(const LAS bf16x8*)(lds + PG8_SA(b, h) + aoff + m * 2048 + k * 1024); } while (0)
#define PG8_LDB(dst, b, h) do { _Pragma("unroll") for (int n = 0; n < 2; ++n) _Pragma("unroll") for (int k = 0; k < 2; ++k) dst[n][k] = *(const LAS bf16x8*)(lds + PG8_SB(b, h) + boff + n * 2048 + k * 1024); } while (0)
#define PG8_MMA(ai, bj, At, Bt) do { __builtin_amdgcn_s_setprio(1); _Pragma("unroll") for (int m = 0; m < 4; ++m) _Pragma("unroll") for (int n = 0; n < 2; ++n) _Pragma("unroll") for (int k = 0; k < 2; ++k) \
        acc[ai][bj][m][n] = __builtin_amdgcn_mfma_f32_16x16x32_bf16(Bt[n][k], At[m][k], acc[ai][bj][m][n], 0, 0, 0); __builtin_amdgcn_s_setprio(0); } while (0)
#define PG8_WAIT_V(n) asm volatile("s_waitcnt vmcnt(" #n ")" ::: "memory")
#define PG8_WAIT_L(n) asm volatile("s_waitcnt lgkmcnt(" #n ")" ::: "memory")
#define PG8_BAR __builtin_amdgcn_s_barrier()
#define PG8_SCHED __builtin_amdgcn_sched_barrier(0)
    Unit cur, nxt; int ui = 0;
    if (!S.next(0, cur)) return;
    f32x4 acc[2][2][4][2];
#pragma unroll
    for (int a = 0; a < 2; ++a)
#pragma unroll
        for (int b = 0; b < 2; ++b)
#pragma unroll
            for (int m = 0; m < 4; ++m)
#pragma unroll
                for (int n = 0; n < 2; ++n) acc[a][b][m][n] = (f32x4){0.f, 0.f, 0.f, 0.f};
    bf16x8 At[4][2], B0[2][2], B1[2][2];
    const char* cA = S.aptr(cur); const char* cB = S.bptr(cur);
    PG8_STAGE_B(PG8_SB(0, 0), cB); PG8_STAGE_B(PG8_SB(0, 1), cB + hstep); PG8_STAGE_A(PG8_SA(0, 0), cA, cur.slot, 0, 0); PG8_STAGE_A(PG8_SA(0, 1), cA, cur.slot, 1, 0);
    if (wr == 1) PG8_BAR;
    PG8_WAIT_V(2); PG8_BAR;
    PG8_STAGE_B(PG8_SB(1, 0), cB + kstep); PG8_STAGE_A(PG8_SA(1, 0), cA, cur.slot, 0, kstep); PG8_STAGE_B(PG8_SB(1, 1), cB + hstep + kstep);
    PG8_WAIT_V(6); PG8_BAR;
    for (;;) {
        const bool has_next = S.next(ui + 1, nxt);
        const char* nA = has_next ? S.aptr(nxt) : cA; const char* nB = has_next ? S.bptr(nxt) : cB; const int nslot = has_next ? nxt.slot : cur.slot;
        for (int t = 0; t < nt; t += 2) {
            const bool last = (t == nt - 2);
            const size_t k1 = (size_t)(t + 1) * kstep;
            const size_t k2 = last ? (size_t)0 : (size_t)(t + 2) * kstep, k3 = k2 + kstep;
            const char* a2 = last ? nA : cA; const int s2 = last ? nslot : cur.slot;
            const char* b2 = last ? nB : cB + (size_t)(t + 2) * kstep; const char* b3 = b2 + kstep;
            PG8_LDB(B0, 0, 0); PG8_LDB(B1, 0, 1); PG8_SCHED; PG8_LDA(At, 0, 0); PG8_STAGE_A(PG8_SA(1, 1), cA, cur.slot, 1, k1);
            PG8_WAIT_V(8); PG8_WAIT_L(0); PG8_BAR; PG8_MMA(0, 0, At, B0); PG8_MMA(0, 1, At, B1); PG8_BAR; PG8_SCHED;
            PG8_LDA(At, 0, 1); PG8_STAGE_B(PG8_SB(0, 0), b2); PG8_STAGE_B(PG8_SB(0, 1), b2 + hstep); PG8_STAGE_A(PG8_SA(0, 0), a2, s2, 0, k2);
            PG8_WAIT_V(8); PG8_WAIT_L(0); PG8_BAR; PG8_MMA(1, 0, At, B0); PG8_MMA(1, 1, At, B1); PG8_BAR; PG8_SCHED;
            PG8_LDB(B0, 1, 0); PG8_LDB(B1, 1, 1); PG8_SCHED; PG8_LDA(At, 1, 0); PG8_STAGE_A(PG8_SA(0, 1), a2, s2, 1, k2);
            PG8_WAIT_V(8); PG8_WAIT_L(0); PG8_BAR; PG8_MMA(0, 0, At, B0); PG8_MMA(0, 1, At, B1); PG8_BAR; PG8_SCHED;
            PG8_LDA(At, 1, 1); PG8_STAGE_B(PG8_SB(1, 0), b3); PG8_STAGE_B(PG8_SB(1, 1), b3 + hstep); PG8_STAGE_A(PG8_SA(1, 0), a2, s2, 0, k3);
            PG8_WAIT_V(8); PG8_WAIT_L(0); PG8_BAR; PG8_MMA(1, 0, At, B0); PG8_MMA(1, 1, At, B1); PG8_BAR; PG8_SCHED;
        }
        if constexpr (ALIGN_EPI) { if (wr == 0) PG8_BAR; }
        E(acc, cur, wr, wc, fr, fq);
        if (!has_next) break;
#pragma unroll
        for (int a = 0; a < 2; ++a)
#pragma unroll
            for (int b = 0; b < 2; ++b)
#pragma unroll
                for (int m = 0; m < 4; ++m)
#pragma unroll
                    for (int n = 0; n < 2; ++n) acc[a][b][m][n] = (f32x4){0.f, 0.f, 0.f, 0.f};
        cur = nxt; cA = nA; cB = nB; ++ui;
        if constexpr (ALIGN_EPI) { if (wr == 1) PG8_BAR; }
    }
    PG8_WAIT_V(0);
    if constexpr (!ALIGN_EPI) { if (wr == 0) PG8_BAR; }
    PG8_BAR;
#undef PG8_SA
#undef PG8_SB
#undef PG8_STAGE_A
#undef PG8_STAGE_B
#undef PG8_LDA
#undef PG8_LDB
#undef PG8_MMA
#undef PG8_WAIT_V
#undef PG8_WAIT_L
#undef PG8_BAR
#undef PG8_SCHED
}

struct DenseSched {
    static constexpr bool GATHER = false;
    int nM, nN, nwg, G, c, K; const char* A; const char* Bt; const LAS unsigned* toff;
    __device__ void init(int M, int N, int K_, int G_, int c_, const void* A_, const void* Bt_) { nM = M / BM; nN = N / BM; nwg = nM * nN; G = G_; c = c_; K = K_; A = (const char*)A_; Bt = (const char*)Bt_; toff = nullptr; }
    __device__ __forceinline__ bool next(int i, Unit& u) const {
        const long L = (long)i * G + c; if (L >= nwg) return false;
        int wgid = (int)L; { const int q = nwg / NXCD, r = nwg % NXCD, xcd = wgid % NXCD, off = wgid / NXCD; wgid = (xcd < r ? xcd * (q + 1) : r * (q + 1) + (xcd - r) * q) + off; }
        const int nig = WGM * nN, gid = wgid / nig, fm = gid * WGM, gsz = (nM - fm) < WGM ? (nM - fm) : WGM;
        u.pm = fm + ((wgid % nig) % gsz); u.pn = (wgid % nig) / gsz; u.e = 0; u.slot = i; return true;
    }
    __device__ __forceinline__ const char* aptr(const Unit& u) const { return A + (size_t)u.pm * BM * K * 2; }
    __device__ __forceinline__ const char* bptr(const Unit& u) const { return Bt + (size_t)u.pn * BM * K * 2; }
};
}

struct Params {
    const float* x; const float* c; const int* pos; const float* w_ada; const float* b_ada; const float* g_mix; const float* w_in; const float* b_forget;
    const float* lq1; const float* lk1; const float* lq2; const float* lk2; const float* g_subln; const float* g_fox; const float* w_out; const float* g_ffn;
    const float* wrg; const float* brg; const float* wre; const float* bre; const float* wg; const float* wu; const float* wd; const float* g_final;
    float* out; unsigned char* ws; int ph_lo, ph_hi;
};
typedef const __attribute__((address_space(4))) Params* KP;
struct Frame {
    LAS unsigned char* lds;
    volatile LAS unsigned* MISC;
    gu32* ctl;
    int wave, vcu, G;
    unsigned char* ws;
};

constexpr int CONV_NIT = 16 * 96 + 16 * 32 + 3 * NEXP * 256;
struct ConvItem { const float* W; bf16_t* WT; int ldw, K, k0, n0, drow0; };
__device__ __forceinline__ ConvItem conv_decode(KP P, unsigned char* ws, int l, int r) {
    ConvItem c;
    if (r < 1536) { const int kb = r / 96, nb = r % 96; c.W = P->w_in + (size_t)l * 1024 * INC; c.ldw = INC; c.K = 1024; c.WT = (bf16_t*)(ws + WS_WIN) + (size_t)l * NQKV * 1024; c.k0 = 64 * kb; c.n0 = 32 * nb; c.drow0 = 32 * nb; return c; }
    r -= 1536;
    if (r < 512) { const int kb = r / 32, nb = r % 32; c.W = P->w_out + (size_t)l * 1024 * 1024; c.ldw = 1024; c.K = 1024; c.WT = (bf16_t*)(ws + WS_WOUT) + (size_t)l * 1024 * 1024; c.k0 = 64 * kb; c.n0 = 32 * nb; c.drow0 = 32 * nb; return c; }
    r -= 512;
    if (r < 2 * NEXP * 256) { const int up = r >= NEXP * 256; if (up) r -= NEXP * 256; const int le = l * NEXP + r / 256, q = r % 256, kb = q / 16, nb = q % 16, n0 = 32 * nb;
        c.W = (up ? P->wu : P->wg) + (size_t)le * 1024 * 512; c.ldw = 512; c.K = 1024; c.WT = (bf16_t*)(ws + WS_WGU) + (size_t)le * 1024 * 1024; c.k0 = 64 * kb; c.n0 = n0; c.drow0 = (n0 >> 7) * 256 + (n0 & 127) + (up ? 128 : 0); return c; }
    r -= 2 * NEXP * 256;
    { const int le = l * NEXP + r / 256, q = r % 256, kb = q / 32, nb = q % 32; c.W = P->wd + (size_t)le * 512 * 1024; c.ldw = 1024; c.K = 512; c.WT = (bf16_t*)(ws + WS_WD) + (size_t)le * 1024 * 512; c.k0 = 64 * kb; c.n0 = 32 * nb; c.drow0 = 32 * nb; }
    return c;
}
constexpr int CONV_NMOE = 3 * NEXP * 256, CONV_NDENSE = 16 * 96 + 16 * 32;
__device__ __forceinline__ ConvItem conv_decode_ph(KP P, unsigned char* ws, int l, int r) { return (r < CONV_NMOE) ? conv_decode(P, ws, l, r + CONV_NDENSE) : conv_decode(P, ws, l + 1, r - CONV_NMOE); }
__device__ __forceinline__ void conv_issue(const ConvItem& c, LAS unsigned char* buf, int lane) {
    const unsigned lo = (unsigned)((lane >> 3) * c.ldw + (lane & 7) * 4) * 4u;
    const char* base = (const char*)(c.W + (size_t)c.k0 * c.ldw + c.n0);
#pragma unroll
    for (int i = 0; i < 8; ++i) __builtin_amdgcn_global_load_lds((const unsigned*)(base + (size_t)i * 8 * c.ldw * 4 + lo), (LAS unsigned*)(buf + i * 1056), 16, 0, 2);
}
__device__ __forceinline__ void conv_consume(const ConvItem& c, const LAS unsigned char* buf, int lane) {
    const LAS float* s = (const LAS float*)buf + (lane & 7) * 264 + (lane >> 3);
    bf16_t* d = c.WT + (size_t)(c.drow0 + (lane >> 3)) * c.K + c.k0 + (lane & 7) * 8;
#pragma unroll
    for (int j = 0; j < 4; ++j) { u32x4 o; o.x = cvtpk(s[8 * j], s[8 * j + 32]); o.y = cvtpk(s[8 * j + 64], s[8 * j + 96]); o.z = cvtpk(s[8 * j + 128], s[8 * j + 160]); o.w = cvtpk(s[8 * j + 192], s[8 * j + 224]);
        __builtin_nontemporal_store(o, (GAS u32x4*)(d + (size_t)(8 * j) * c.K)); asm volatile("" ::: "memory"); }
}

__device__ __forceinline__ void p0_transpose_item(const float* W, int ldw, int K, bf16_t* WT, int k0, int n0, int drow0, LAS float* scr, int lane) {
#pragma unroll 8
    for (int i = 0; i < 32; ++i) { const int kk = 2 * i + (lane >> 5); scr[kk * 33 + (lane & 31)] = __builtin_nontemporal_load(W + (size_t)(k0 + kk) * ldw + n0 + (lane & 31)); }
    LDS_WAIT(); asm volatile("" ::: "memory");
    const int c = lane & 7;
#pragma unroll
    for (int j = 0; j < 4; ++j) { const int n = (lane >> 3) + 8 * j; const LAS float* s = scr + (8 * c) * 33 + n;
        u32x4 o; o.x = pk2(s[0 * 33], s[1 * 33]); o.y = pk2(s[2 * 33], s[3 * 33]); o.z = pk2(s[4 * 33], s[5 * 33]); o.w = pk2(s[6 * 33], s[7 * 33]);
        __builtin_nontemporal_store(o, (GAS u32x4*)(WT + (size_t)(drow0 + n) * K + k0 + 8 * c)); }
    LDS_WAIT(); asm volatile("" ::: "memory");
}
__device__ __forceinline__ void sincos_d(double a, double& s, double& c) {
    const double TWO_OVER_PI = 0.63661977236758134308, PIO2_H = 1.57079632673412561417e+00, PIO2_L = 6.07710050650619224932e-11;
    const double kq = __builtin_rint(a * TWO_OVER_PI);
    double r = (a - kq * PIO2_H) - kq * PIO2_L;
    const int q = ((int)kq) & 3;
    const double r2 = r * r;
    double sp = -7.6471637318198164759e-13;
    sp = sp * r2 + 1.6059043836821614599e-10; sp = sp * r2 - 2.5052108385441718775e-08; sp = sp * r2 + 2.7557319223985890653e-06; sp = sp * r2 - 1.9841269841269841270e-04;
    sp = sp * r2 + 8.3333333333333333333e-03; sp = sp * r2 - 1.6666666666666666667e-01; const double sr = r + r * r2 * sp;
    double cp = 4.7794773323873852974e-14;
    cp = cp * r2 - 1.1470745597729724714e-11; cp = cp * r2 + 2.0876756987868098979e-09; cp = cp * r2 - 2.7557319223985890653e-07; cp = cp * r2 + 2.4801587301587301587e-05;
    cp = cp * r2 - 1.3888888888888888889e-03; cp = cp * r2 + 4.1666666666666666667e-02; cp = cp * r2 - 0.5; const double cr = 1.0 + r2 * cp;
    s = (q == 0) ? sr : (q == 1) ? cr : (q == 2) ? -sr : -cr;
    c = (q == 0) ? cr : (q == 1) ? -sr : (q == 2) ? -cr : sr;
}
__device__ __forceinline__ void p0_prologue(Frame& F, KP P) {
    const int tid = otid(), lane = tid & 63, wave = F.wave;
    {
        LAS float* cs = (LAS float*)(F.lds);
        LAS float* red = (LAS float*)(F.lds + 16384);
        for (int i = tid; i < 4096; i += 512) { const float v = P->c[i]; cs[i] = v / (1.f + __expf(-v)); }
        __syncthreads();
        float* mod = (float*)(F.ws + WS_MOD);
        for (int it = F.vcu; it < DEPTH * 96; it += F.G) {
            const int l = it / 96, n = (it % 96) * 64 + lane;
            const float* w = P->w_ada + ((size_t)l * 1024 + wave * 128) * 6144 + n;
            float a0 = 0.f, a1 = 0.f, a2 = 0.f, a3 = 0.f;
#pragma unroll 16
            for (int k = 0; k < 128; ++k) { const float wv = __builtin_nontemporal_load(w + (size_t)k * 6144); const int kk = wave * 128 + k; a0 += cs[kk] * wv; a1 += cs[1024 + kk] * wv; a2 += cs[2048 + kk] * wv; a3 += cs[3072 + kk] * wv; }
            red[(wave * 4 + 0) * 64 + lane] = a0; red[(wave * 4 + 1) * 64 + lane] = a1; red[(wave * 4 + 2) * 64 + lane] = a2; red[(wave * 4 + 3) * 64 + lane] = a3;
            __syncthreads();
            if (tid < 256) { const int b = tid >> 6, ln = tid & 63; float s = 0.f;
#pragma unroll
                for (int w8 = 0; w8 < 8; ++w8) s += red[(w8 * 4 + b) * 64 + ln];
                const int nn = (it % 96) * 64 + ln; mod[((size_t)l * 4 + b) * 6144 + nn] = s + P->b_ada[(size_t)l * 6144 + nn]; }
            __syncthreads();
        }
    }
    const int gt = F.vcu * 512 + tid, NGT = F.G * 512;
    {
        float* rope = (float*)(F.ws + WS_ROPE);
        for (int idx = gt; idx < NTOK * 8; idx += NGT) { const int tok = idx >> 3, i = idx & 7;
            const float inv = (i == 0) ? 1.0f : (i == 1) ? 0.1939227432012558f : (i == 2) ? 0.03760603070259094f : (i == 3) ? 0.007292664609849453f : (i == 4) ? 0.0014142135623842478f
                            : (i == 5) ? 0.00027424818836152554f : (i == 6) ? 5.318296098266728e-05f : 1.0313386155758053e-05f;
            const float ang = (float)P->pos[tok] * inv; double s, c; sincos_d((double)ang, s, c);
            rope[tok * 16 + i] = (float)c; rope[tok * 16 + 8 + i] = (float)s; }
    }
    {
        float* winf = (float*)(F.ws + WS_WINF); float* wrt = (float*)(F.ws + WS_WRT);
        for (int idx = gt; idx < DEPTH * 8 * 1024; idx += NGT) { const int k = idx & 1023, j = (idx >> 10) & 7, l = idx >> 13; winf[idx] = P->w_in[((size_t)l * 1024 + k) * INC + NQKV + j]; }
        for (int idx = gt; idx < DEPTH * 36 * 1024; idx += NGT) { const int k = idx & 1023, j = (idx >> 10) % 36, l = (idx >> 10) / 36;
            wrt[idx] = (j < 4) ? P->wrg[((size_t)l * 1024 + k) * 4 + j] : P->wre[((size_t)l * 1024 + k) * 32 + (j - 4)]; }
    }
    __syncthreads();
    {
        LAS float* scr = (LAS float*)(F.lds + wave * 16384);
        const int gw = F.vcu * 8 + wave, NGW = F.G * 8;
        const int nconv = (F.G >= 128) ? CONV_NDENSE : DEPTH * CONV_NIT;
        for (int it = gw; it < nconv; it += NGW) {
            const ConvItem c = conv_decode(P, F.ws, it / CONV_NIT, it % CONV_NIT);
            p0_transpose_item(c.W, c.ldw, c.K, c.WT, c.k0, c.n0, c.drow0, scr, lane);
        }
    }
}

__device__ __forceinline__ float log_sigmoid(float x) { return fminf(x, 0.f) - log1pf(__expf(-fabsf(x))); }

__device__ __forceinline__ void phase_norm1(Frame& F, KP P, const int l) {
    const int tid_ = otid();
    const int lane = tid_ & 63; const bool first = (l == 0), fin = (l == DEPTH);
    const float* mod = (const float*)(F.ws + WS_MOD);
    const bf16_t* ys = (const bf16_t*)(F.ws + WS_YS); bf16_t* xb = (bf16_t*)(F.ws + WS_X);
    bf16_t* hb = (bf16_t*)(F.ws + WS_H); float* lf = (float*)(F.ws + WS_LF);
    const float* winf = (const float*)(F.ws + WS_WINF) + (size_t)(fin ? 0 : l) * 8 * 1024;
    int gw = F.vcu * 8 + F.wave; asm volatile("" : "+s"(gw)); const int NGW = F.G * 8;
    if (!fin) {
#pragma unroll
        for (int i = 0; i < 4; ++i) { const int p = F.wave * 4 + i; __builtin_amdgcn_global_load_lds((const unsigned*)(winf + p * 256 + lane * 4), (LAS unsigned*)(F.lds + p * 1024), 16, 0, 0); }
    }
    bool staged = fin;
    for (int rb = gw; rb < NTOK / 8; rb += NGW) {
        const int row0 = rb * 8, b = row0 >> 12;
        f32x4 g[4], sc[4], sh[4], gp[4];
        const float* gsrc = fin ? P->g_final : P->g_mix + (size_t)l * 1024;
#pragma unroll
        for (int j = 0; j < 4; ++j) { g[j] = *(const f32x4*)(gsrc + 4 * lane + 256 * j); gp[j] = (f32x4){0.f, 0.f, 0.f, 0.f}; sc[j] = gp[j]; sh[j] = gp[j]; }
        if (!fin) {
            const float* m = mod + ((size_t)l * 4 + b) * 6144;
#pragma unroll
            for (int j = 0; j < 4; ++j) { sh[j] = *(const GAS f32x4*)(m + 4 * lane + 256 * j); sc[j] = *(const GAS f32x4*)(m + 1024 + 4 * lane + 256 * j); }
        }
        if (!first) { const float* m = mod + ((size_t)(l - 1) * 4 + b) * 6144 + 5 * 1024;
#pragma unroll
            for (int j = 0; j < 4; ++j) gp[j] = *(const GAS f32x4*)(m + 4 * lane + 256 * j); }
        f32x4 vn[4]; u32x2 xn[4], yan[4], ybn[4];
#define A_LOAD(row_) do { if (first) { _Pragma("unroll") for (int j = 0; j < 4; ++j) vn[j] = *(const f32x4*)(P->x + (size_t)(row_) * 1024 + 4 * lane + 256 * j); } \
            else { _Pragma("unroll") for (int j = 0; j < 4; ++j) { xn[j] = *(const GAS u32x2*)(xb + (size_t)(row_) * 1024 + 4 * lane + 256 * j); \
                yan[j] = *(const GAS u32x2*)(ys + (size_t)(2 * (row_)) * 1024 + 4 * lane + 256 * j); ybn[j] = *(const GAS u32x2*)(ys + (size_t)(2 * (row_) + 1) * 1024 + 4 * lane + 256 * j); } } } while (0)
        A_LOAD(row0);
        if (!staged) { asm volatile("s_waitcnt vmcnt(0)" ::: "memory"); __syncthreads(); staged = true; }
        for (int rr = 0; rr < 8; ++rr) {
            const int row = row0 + rr;
            f32x4 v[4]; u32x2 xa[4], ya[4], yb[4];
#pragma unroll
            for (int j = 0; j < 4; ++j) { v[j] = vn[j]; xa[j] = xn[j]; ya[j] = yan[j]; yb[j] = ybn[j]; }
            if (rr + 1 < 8) A_LOAD(row + 1);
            if (!first) {
#pragma unroll
                for (int j = 0; j < 4; ++j) { const u32x2 a = ya[j], bb = yb[j]; v[j] = (f32x4){bflo(xa[j].x), bfhi(xa[j].x), bflo(xa[j].y), bfhi(xa[j].y)};
                    v[j].x += gp[j].x * (bflo(a.x) + bflo(bb.x)); v[j].y += gp[j].y * (bfhi(a.x) + bfhi(bb.x)); v[j].z += gp[j].z * (bflo(a.y) + bflo(bb.y)); v[j].w += gp[j].w * (bfhi(a.y) + bfhi(bb.y)); }
            }
            float ss = 0.f;
#pragma unroll
            for (int j = 0; j < 4; ++j) ss += (v[j].x * v[j].x + v[j].y * v[j].y) + (v[j].z * v[j].z + v[j].w * v[j].w);
            const float rstd = __builtin_amdgcn_rsqf(wave_sum(ss) * (1.f / 1024.f) + EPS);
            if (fin) {
#pragma unroll
                for (int j = 0; j < 4; ++j) __builtin_nontemporal_store(v[j] * rstd * g[j], (GAS f32x4*)(P->out + (size_t)row * 1024 + 4 * lane + 256 * j));
                continue;
            }
#pragma unroll
            for (int j = 0; j < 4; ++j) { u32x2 o; o.x = cvtpk(v[j].x, v[j].y); o.y = cvtpk(v[j].z, v[j].w); *(GAS u32x2*)(xb + (size_t)row * 1024 + 4 * lane + 256 * j) = o; }
            f32x4 h[4];
#pragma unroll
            for (int j = 0; j < 4; ++j) { h[j] = (v[j] * rstd * g[j]) * (sc[j] + 1.0f) + sh[j];
                u32x2 o; o.x = cvtpk(h[j].x, h[j].y); o.y = cvtpk(h[j].z, h[j].w); *(GAS u32x2*)(hb + (size_t)row * 1024 + 4 * lane + 256 * j) = o; }
            float ff[8];
#pragma unroll
            for (int q = 0; q < 8; ++q) { f32x4 a4 = h[0] * *(const LAS f32x4*)(F.lds + (q * 1024 + 4 * lane) * 4);
#pragma unroll
                for (int j = 1; j < 4; ++j) a4 = a4 + h[j] * *(const LAS f32x4*)(F.lds + (q * 1024 + 4 * lane + 256 * j) * 4);
                ff[q] = wave_sum((a4.x + a4.y) + (a4.z + a4.w)); if ((q & 3) == 3) asm volatile("" ::: "memory"); }
            float mine = 0.f;
#pragma unroll
            for (int q = 0; q < 8; ++q) mine = (lane == q) ? ff[q] : mine;
            if (lane < 8) lf[(size_t)row * 8 + lane] = log_sigmoid(mine + P->b_forget[l * 8 + lane]);
        }
    }
    if (!staged) { asm volatile("s_waitcnt vmcnt(0)" ::: "memory"); __syncthreads(); }
}

__device__ __forceinline__ void phase_router(Frame& F, KP P, const int l) {
    const int tid_ = otid();
    const int lane = tid_ & 63, tid = tid_;
    const float* mod = (const float*)(F.ws + WS_MOD);
    bf16_t* hb = (bf16_t*)(F.ws + WS_H); const bf16_t* xb = (const bf16_t*)(F.ws + WS_X);
    const float* wrt = (const float*)(F.ws + WS_WRT) + (size_t)l * 36 * 1024;
    int* list = (int*)(F.ws + WS_LIST); float* wlist = (float*)(F.ws + WS_WLIST);
    unsigned* gcnt = (unsigned*)F.ctl + CW_CNT + l * 32 * 64;
    volatile LAS unsigned* lcnt = F.MISC + 32;
    volatile LAS unsigned* lbase = F.MISC + 64;
    {
#pragma unroll
        for (int i = 0; i < 16; ++i) { const int p = F.wave * 16 + i; __builtin_amdgcn_global_load_lds((const unsigned*)(wrt + 4 * 1024 + p * 256 + lane * 4), (LAS unsigned*)(F.lds + p * 1024), 16, 0, 0); }
    }
    for (int blk = F.vcu; blk < NTOK / 64; blk += F.G) {
        if (tid < 32) lcnt[tid] = 0u;
        const int row0 = blk * 64 + F.wave * 8, b = row0 >> 12;
        f32x4 g[4], sc[4], sh[4];
        const float* m = mod + ((size_t)l * 4 + b) * 6144;
#pragma unroll
        for (int j = 0; j < 4; ++j) { g[j] = *(const f32x4*)(P->g_ffn + (size_t)l * 1024 + 4 * lane + 256 * j); sh[j] = *(const GAS f32x4*)(m + 3 * 1024 + 4 * lane + 256 * j); sc[j] = *(const GAS f32x4*)(m + 4 * 1024 + 4 * lane + 256 * j); }
        int myE = 0, myEnt = 0; float myW = 0.f;
        f32x4 wg[4][4];
#pragma unroll
        for (int q = 0; q < 4; ++q)
#pragma unroll
            for (int j = 0; j < 4; ++j) wg[q][j] = *(const GAS f32x4*)(wrt + q * 1024 + 4 * lane + 256 * j);
        u32x2 vn[4];
#pragma unroll
        for (int j = 0; j < 4; ++j) vn[j] = *(const GAS u32x2*)(xb + (size_t)row0 * 1024 + 4 * lane + 256 * j);
        asm volatile("s_waitcnt vmcnt(0)" ::: "memory"); __syncthreads();
        for (int rr = 0; rr < 8; ++rr) {
            const int row = row0 + rr;
            f32x4 v[4];
#pragma unroll
            for (int j = 0; j < 4; ++j) v[j] = (f32x4){bflo(vn[j].x), bfhi(vn[j].x), bflo(vn[j].y), bfhi(vn[j].y)};
            if (rr + 1 < 8) {
#pragma unroll
                for (int j = 0; j < 4; ++j) vn[j] = *(const GAS u32x2*)(xb + (size_t)(row + 1) * 1024 + 4 * lane + 256 * j);
            }
            float ss = 0.f;
#pragma unroll
            for (int j = 0; j < 4; ++j) ss += (v[j].x * v[j].x + v[j].y * v[j].y) + (v[j].z * v[j].z + v[j].w * v[j].w);
            const float rstd = __builtin_amdgcn_rsqf(wave_sum(ss) * (1.f / 1024.f) + EPS);
            f32x4 h[4];
#pragma unroll
            for (int j = 0; j < 4; ++j) { h[j] = (v[j] * rstd * g[j]) * (sc[j] + 1.0f) + sh[j];
                u32x2 o; o.x = cvtpk(h[j].x, h[j].y); o.y = cvtpk(h[j].z, h[j].w); *(GAS u32x2*)(hb + (size_t)row * 1024 + 4 * lane + 256 * j) = o; }
            float gl[4];
#pragma unroll
            for (int q = 0; q < 4; ++q) { f32x4 a4 = h[0] * wg[q][0];
#pragma unroll
                for (int j = 1; j < 4; ++j) a4 = a4 + h[j] * wg[q][j];
                gl[q] = wave_sum((a4.x + a4.y) + (a4.z + a4.w)) + P->brg[l * 4 + q]; }
            int gs = 0; float gm = gl[0];
#pragma unroll
            for (int q = 1; q < 4; ++q) if (gl[q] > gm) { gm = gl[q]; gs = q; }
            float den = 0.f;
#pragma unroll
            for (int q = 0; q < 4; ++q) den += __expf(gl[q] - gm);
            const float pg = 1.0f / den;
            gs = __builtin_amdgcn_readfirstlane(gs);
            float el[8];
            const LAS unsigned char* wsel = F.lds + (size_t)(gs * 8) * 4096;
#pragma unroll
            for (int i = 0; i < 8; ++i) { f32x4 a4 = h[0] * *(const LAS f32x4*)(wsel + (i * 1024 + 4 * lane) * 4);
#pragma unroll
                for (int j = 1; j < 4; ++j) a4 = a4 + h[j] * *(const LAS f32x4*)(wsel + (i * 1024 + 4 * lane + 256 * j) * 4);
                el[i] = (a4.x + a4.y) + (a4.z + a4.w);
                if (i & 1) asm volatile("" ::: "memory"); }
#pragma unroll
            for (int i = 0; i < 8; ++i) el[i] = wave_sum(el[i]) + P->bre[l * 32 + gs * 8 + i];
            int i1 = 0; float l1 = el[0];
#pragma unroll
            for (int i = 1; i < 8; ++i) if (el[i] > l1) { l1 = el[i]; i1 = i; }
            int i2 = -1; float l2 = -3.0e38f;
#pragma unroll
            for (int i = 0; i < 8; ++i) if (i != i1 && el[i] > l2) { l2 = el[i]; i2 = i; }
            const float e21 = __expf(l2 - l1), w1 = pg / (1.0f + e21), w2 = pg * e21 / (1.0f + e21);
            if (lane == 2 * rr) { myE = gs * 8 + i1; myW = w1; myEnt = row * 2; }
            if (lane == 2 * rr + 1) { myE = gs * 8 + i2; myW = w2; myEnt = row * 2 + 1; }
        }
        unsigned lpos = 0u;
        if (lane < 16) lpos = __hip_atomic_fetch_add((LAS unsigned*)&lcnt[myE], 1u, __ATOMIC_RELAXED, __HIP_MEMORY_SCOPE_WORKGROUP);
        __syncthreads();
        if (tid < 32) { const unsigned n = lcnt[tid]; lbase[tid] = n ? __hip_atomic_fetch_add(gcnt + tid * 64, n, __ATOMIC_RELAXED, __HIP_MEMORY_SCOPE_AGENT) : 0u; }
        __syncthreads();
        if (lane < 16) { const unsigned p = lbase[myE] + lpos; list[(size_t)myE * NTOK + p] = myEnt; wlist[(size_t)myE * NTOK + p] = myW; }
        __syncthreads();
    }
}

__device__ __forceinline__ void scan_item(Frame& F, int bh) {
    const int tid_ = otid();
    const int tid = tid_, lane = tid & 63, wave = F.wave, b = bh >> 3, hh = bh & 7;
    const float* lf = (const float*)(F.ws + WS_LF); float* cf = (float*)(F.ws + WS_CF) + (size_t)bh * SEQ;
    LAS float* sw = (LAS float*)(F.lds + TAB_OFF);
    float v[8]; float s = 0.f;
#pragma unroll
    for (int i = 0; i < 8; ++i) { v[i] = *(const GAS float*)(lf + ((size_t)b * SEQ + tid * 8 + i) * 8 + hh); s += v[i]; v[i] = s; }
    float inc = s;
#define SCAN_DPP(ctrl, rm) inc += __builtin_bit_cast(float, __builtin_amdgcn_update_dpp(0, __builtin_bit_cast(int, inc), ctrl, rm, 0xF, false))
    SCAN_DPP(0x111, 0xF); SCAN_DPP(0x112, 0xF); SCAN_DPP(0x114, 0xF); SCAN_DPP(0x118, 0xF); SCAN_DPP(0x142, 0xA); SCAN_DPP(0x143, 0xC);
#undef SCAN_DPP
    if (lane == 63) sw[wave] = inc;
    __syncthreads();
    float base = inc - s;
    for (int w = 0; w < wave; ++w) base += sw[w];
#pragma unroll
    for (int i = 0; i < 8; ++i) cf[tid * 8 + i] = -(base + v[i]) * LOG2E;
    __syncthreads();
}

using pg8::Unit;
struct EpiQKV {
    bf16_t* O; const float* rope;
    __device__ __forceinline__ void operator()(const f32x4 (&acc)[2][2][4][2], const Unit& u, int wr, int wc, int fr, int fq) const {
        const int colt = u.pn * 256, region = colt >> 9;
        const float sc = (region == 0 || region == 3) ? C2 : 1.0f;
        const bool do_rope = region < 2, rot = ((wc & 1) == 0) && (fq < 2);
        const float sgn = (fq == 0) ? -1.0f : 1.0f;
        const int col0 = colt + wc * 32 + 8 * fq;
        f32x4 ncs0 = {1.f, 1.f, 1.f, 1.f}, ncs1 = ncs0, nsn0 = {0.f, 0.f, 0.f, 0.f}, nsn1 = nsn0;
        if (do_rope) { const GAS f32x4* rp = (const GAS f32x4*)(rope + (size_t)(u.pm * 256 + wr * 64 + fr) * 16); ncs0 = rp[0]; ncs1 = rp[1]; nsn0 = rp[2]; nsn1 = rp[3]; }
#pragma unroll
        for (int gi = 0; gi < 8; ++gi) {
                const int ai = gi >> 2, m = gi & 3;
                const int row = u.pm * 256 + ai * 128 + wr * 64 + m * 16 + fr;
                const f32x4 cs0 = ncs0, cs1 = ncs1, sn0 = nsn0, sn1 = nsn1;
                if (do_rope && gi + 1 < 8) { const int nrow = u.pm * 256 + ((gi + 1) >> 2) * 128 + wr * 64 + ((gi + 1) & 3) * 16 + fr; const GAS f32x4* rp = (const GAS f32x4*)(rope + (size_t)nrow * 16); ncs0 = rp[0]; ncs1 = rp[1]; nsn0 = rp[2]; nsn1 = rp[3]; }
                bf16_t* rowp = O + (size_t)row * NQKV + col0;
#pragma unroll
                for (int bj = 0; bj < 2; ++bj) {
                    f32x4 v0 = acc[ai][bj][m][0], v1 = acc[ai][bj][m][1];
                    if (do_rope) {
                        f32x4 p0, p1;
#pragma unroll
                        for (int k = 0; k < 4; ++k) { p0[k] = xor16_f(v0[k]); p1[k] = xor16_f(v1[k]); }
                        if (rot) { v0 = v0 * cs0 + p0 * sn0 * sgn; v1 = v1 * cs1 + p1 * sn1 * sgn; }
                    }
                    v0 = v0 * sc; v1 = v1 * sc;
                    u32x4 w; w.x = cvtpk(v0[0], v0[1]); w.y = cvtpk(v0[2], v0[3]); w.z = cvtpk(v1[0], v1[1]); w.w = cvtpk(v1[2], v1[3]);
                    *(GAS u32x4*)(rowp + bj * 128) = w; }
                asm volatile("" ::: "memory");
        }
    }
};
struct EpiRes {
    bf16_t* X; const float* gt;
    __device__ __forceinline__ void operator()(const f32x4 (&acc)[2][2][4][2], const Unit& u, int wr, int wc, int fr, int fq) const {
        const int col0 = u.pn * 256 + wc * 32 + 8 * fq; const int b = (u.pm * 256) >> 12;
        f32x4 gv[2][2];
#pragma unroll
        for (int bj = 0; bj < 2; ++bj)
#pragma unroll
            for (int n = 0; n < 2; ++n) gv[bj][n] = *(const GAS f32x4*)(gt + (size_t)b * 6144 + col0 + bj * 128 + 4 * n);
#pragma unroll
        for (int ai = 0; ai < 2; ++ai)
#pragma unroll
            for (int m = 0; m < 4; ++m) { bf16_t* rowp = X + (size_t)(u.pm * 256 + ai * 128 + wr * 64 + m * 16 + fr) * 1024 + col0;
#pragma unroll
                for (int bj = 0; bj < 2; ++bj) { GAS u32x4* p = (GAS u32x4*)(rowp + bj * 128); const u32x4 w = *p;
                    const f32x4 v0 = (f32x4){bflo(w.x), bfhi(w.x), bflo(w.y), bfhi(w.y)} + gv[bj][0] * acc[ai][bj][m][0], v1 = (f32x4){bflo(w.z), bfhi(w.z), bflo(w.w), bfhi(w.w)} + gv[bj][1] * acc[ai][bj][m][1];
                    u32x4 o; o.x = cvtpk(v0[0], v0[1]); o.y = cvtpk(v0[2], v0[3]); o.z = cvtpk(v1[0], v1[1]); o.w = cvtpk(v1[2], v1[3]); *p = o; }
                if (m == 3) asm volatile("" ::: "memory"); }
    }
};
struct EpiGU {
    bf16_t* act;
    __device__ __forceinline__ void operator()(const f32x4 (&acc)[2][2][4][2], const Unit& u, int wr, int wc, int fr, int fq) const {
        const int col0 = u.pn * 128 + wc * 32 + 8 * fq;
#pragma unroll
        for (int ai = 0; ai < 2; ++ai)
#pragma unroll
            for (int m = 0; m < 4; ++m) { const int row = u.pm * 256 + ai * 128 + wr * 64 + m * 16 + fr;
                float o[8];
#pragma unroll
                for (int n = 0; n < 2; ++n)
#pragma unroll
                    for (int k = 0; k < 4; ++k) { const float gte = acc[ai][0][m][n][k], up = acc[ai][1][m][n][k]; o[4 * n + k] = gte * __builtin_amdgcn_rcpf(1.0f + __expf(-gte)) * up;        }
                u32x4 w; w.x = cvtpk(o[0], o[1]); w.y = cvtpk(o[2], o[3]); w.z = cvtpk(o[4], o[5]); w.w = cvtpk(o[6], o[7]);
                *(GAS u32x4*)(act + (size_t)row * DEXP + col0) = w; }
    }
};
struct EpiDown {
    bf16_t* ys; const LAS int* tidx; const LAS float* tw;
    __device__ __forceinline__ void operator()(const f32x4 (&acc)[2][2][4][2], const Unit& u, int wr, int wc, int fr, int fq) const {
        const int col0 = u.pn * 256 + wc * 32 + 8 * fq;
#pragma unroll
        for (int ai = 0; ai < 2; ++ai)
#pragma unroll
            for (int m = 0; m < 4; ++m) { const int r = ai * 128 + wr * 64 + m * 16 + fr; const int dst = tidx[u.slot * 256 + r]; const float w = tw[u.slot * 256 + r];
                if (dst >= 0) { bf16_t* rowp = ys + (size_t)dst * 1024 + col0;
#pragma unroll
                    for (int bj = 0; bj < 2; ++bj) { const f32x4 v0 = acc[ai][bj][m][0] * w, v1 = acc[ai][bj][m][1] * w;
                        u32x4 o; o.x = cvtpk(v0[0], v0[1]); o.y = cvtpk(v0[2], v0[3]); o.z = cvtpk(v1[0], v1[1]); o.w = cvtpk(v1[2], v1[3]);
                        *(GAS u32x4*)(rowp + bj * 128) = o; } }
                asm volatile("" ::: "memory"); }
    }
};

constexpr int MAXU = 8, MAXRB = 160;
template <bool GATHER_> struct MoeSched {
    static constexpr bool GATHER = GATHER_;
    const LAS int* rbt;
    const LAS unsigned* toff;
    int G, c, NB, K; const char* A; const char* Bt; size_t bstride;
    __device__ __forceinline__ bool next(int i, Unit& u) const { const int L = i * G + c; if (L >= NB * 4 || i >= MAXU) return false; u.pm = L >> 2; u.pn = L & 3; u.e = rbt[u.pm]; u.slot = i; return true; }
    __device__ __forceinline__ const char* aptr(const Unit& u) const { return A + (size_t)u.pm * 256 * K * 2; }
    __device__ __forceinline__ const char* bptr(const Unit& u) const { return Bt + (size_t)u.e * bstride + (size_t)u.pn * 256 * K * 2; }
};
template <bool GATHER_, bool REUSE> __device__ __forceinline__ void moe_tables(Frame& F, int l, MoeSched<GATHER_>& S) {
    LAS int* rbt = (LAS int*)(F.lds + RBT_OFF); LAS int* T0 = (LAS int*)(F.lds + TAB_OFF); LAS float* T1 = (LAS float*)(F.lds + TAB_OFF + MAXU * 1024); LAS int* T2 = (LAS int*)(F.lds + TENT_OFF);
    const unsigned* gcnt = (const unsigned*)F.ctl + CW_CNT + l * 32 * 64;
    const int* list = (const int*)(F.ws + WS_LIST); const float* wlist = (const float*)(F.ws + WS_WLIST);
    const int tid = otid();
    if (REUSE) { S.rbt = rbt; S.toff = (const LAS unsigned*)T0; S.G = F.G; S.c = F.vcu; S.NB = rbt[480]; return; }
    if (F.wave == 0) {
        const int e = tid & 31;
        const int myc = (tid < 32) ? (int)ld_agent(gcnt + e * 64) : 0;
        const int nblk = (myc + 255) >> 8;
        int base = 0, run = 0;
        for (int k = 0; k < NEXP; ++k) { const int nk = __builtin_amdgcn_readlane(nblk, k); base = (e == k) ? run : base; run += nk; }
        if (tid < 32) for (int j = 0; j < nblk; ++j) { const int nb = base + j; if (nb < MAXRB) { rbt[nb] = e; rbt[160 + nb] = 256 * j; rbt[320 + nb] = (myc - 256 * j) < 256 ? (myc - 256 * j) : 256; } }
        if (tid == 0) rbt[480] = run < MAXRB ? run : MAXRB; }
    __syncthreads();
    const int NB = rbt[480];
    {
        const int half = tid >> 8, r = tid & 255;
        for (int i0 = 0; i0 < MAXU; i0 += 4) {
            if (i0 * F.G + F.vcu >= NB * 4) break;
            int ent2[2]; float w2[2]; bool uv2[2];
#pragma unroll
            for (int p = 0; p < 2; ++p) { const int i = i0 + 2 * p + half, L = i * F.G + F.vcu; const bool uv = L < NB * 4; const int rb = uv ? (L >> 2) : 0;
                const int e = rbt[rb], s0 = rbt[160 + rb], nv = uv ? rbt[320 + rb] : 0; const bool ok = r < nv;
                const size_t li = (size_t)e * NTOK + s0 + (ok ? r : 0);
                const int ev = *(const GAS int*)(list + li); const float wv = *(const GAS float*)(wlist + li);
                uv2[p] = uv; ent2[p] = ok ? ev : -1; w2[p] = ok ? wv : 0.f; }
#pragma unroll
            for (int p = 0; p < 2; ++p) { const int i = i0 + 2 * p + half;
                if (uv2[p]) { T0[i * 256 + r] = (ent2[p] < 0 ? 0 : (ent2[p] >> 1)) * (DM * 2); T1[i * 256 + r] = w2[p]; T2[i * 256 + r] = ent2[p]; } }
        }
    }
    __syncthreads();
    S.rbt = rbt; S.toff = (const LAS unsigned*)T0; S.G = F.G; S.c = F.vcu; S.NB = NB;
}

namespace att {
constexpr float NEG = -1.0e30f;
constexpr float THR = 8.0f;
__device__ __forceinline__ int crow(int r, int hi) { return (r & 3) + 8 * (r >> 2) + 4 * hi; }
__device__ __forceinline__ s16x4 vtr(const LAS char* p) { typedef short v4i16_t __attribute__((ext_vector_type(4))); return __builtin_bit_cast(s16x4, __builtin_amdgcn_ds_read_tr16_b64_v4i16((LAS v4i16_t*)p)); }
__device__ __forceinline__ bf16x8 pack8(const f32x16& p, int s) { u32x4 w; w.x = cvtpk(p[8 * s + 0], p[8 * s + 1]); w.y = cvtpk(p[8 * s + 2], p[8 * s + 3]); w.z = cvtpk(p[8 * s + 4], p[8 * s + 5]); w.w = cvtpk(p[8 * s + 6], p[8 * s + 7]); return __builtin_bit_cast(bf16x8, w); }
__device__ __forceinline__ void dma16(const void* g, LAS unsigned char* l) { __builtin_amdgcn_global_load_lds((const unsigned*)g, (LAS unsigned*)l, 16, 0, 0); }
__device__ __forceinline__ void dma4(const void* g, LAS unsigned char* l) { __builtin_amdgcn_global_load_lds((const unsigned*)g, (LAS unsigned*)l, 4, 0, 0); }
#define ATT_WAIT_BAR() asm volatile("s_waitcnt vmcnt(0) lgkmcnt(0)\n\ts_barrier" ::: "memory")

#define ATT_SB() __builtin_amdgcn_sched_barrier(0)
template <int NSUB, int NDB, bool BIAS, bool MASK>
__device__ __forceinline__ void tileN(const LAS char* K0, const LAS char* V0, const LAS float* B0, const LAS char* K1, const LAS char* V1, const LAS float* B1,
                                      const bf16x8 (&qf)[4], f32x16 (&o)[NDB], float& m, float& l, f32x16& negv, int lane, int dq) {
    static_assert(!MASK || NSUB == 1, "mask only on single tiles");
    const int r32 = lane & 31, hi = lane >> 5;
    constexpr int NQ = NSUB * 4, DQ = (NDB == 4) ? 1 : 3, NP = NSUB * NDB * 4, DP = (NDB == 4) ? 2 : 4;
    f32x16 p[2 * NSUB];
    bf16x8 kb[DQ + 1][2], vbuf[DP + 1];
    const int klane = (r32 >> 4) * 1024 + hi * 256 + (r32 & 15) * 16;
    const LAS char* kl0 = K0 + klane; const LAS char* kl1 = K1 + klane;
    const size_t voff = (size_t)(4 * hi + ((lane & 15) >> 2)) * 64 + ((lane >> 4) & 1) * 32 + (lane & 3) * 8;
    const LAS char* vl0 = V0 + voff; const LAS char* vl1 = V1 + voff;
#define ATT_KLOAD(i_) do { const LAS char* kl_ = (((i_) / 4) ? kl1 : kl0) + (((i_) % 4) >> 1) * 4096 + ((i_) & 1) * 512; kb[(i_) % (DQ + 1)][0] = *(const LAS bf16x8*)(kl_); kb[(i_) % (DQ + 1)][1] = *(const LAS bf16x8*)(kl_ + 2048); } while (0)
#define ATT_VLOAD(j_) do { const LAS char* vl_ = (((j_) / (NDB * 4)) ? vl1 : vl0) + ((j_) % NDB) * 4096 + (((j_) / NDB) % 4) * 1024; const s16x4 lo_ = vtr(vl_), hh_ = vtr(vl_ + 512); \
        vbuf[(j_) % (DP + 1)] = (bf16x8){lo_[0], lo_[1], lo_[2], lo_[3], hh_[0], hh_[1], hh_[2], hh_[3]}; } while (0)
    if (BIAS) {
#pragma unroll
        for (int s = 0; s < NSUB; ++s) { const LAS float* Bs = s ? B1 : B0;
#pragma unroll
            for (int g = 0; g < 4; ++g) { const f32x4 b0 = *(const LAS f32x4*)(Bs + 8 * g + 4 * hi), b1 = *(const LAS f32x4*)(Bs + 32 + 8 * g + 4 * hi);
#pragma unroll
                for (int k = 0; k < 4; ++k) { p[2 * s][4 * g + k] = b0[k]; p[2 * s + 1][4 * g + k] = b1[k]; } } }
    }
#pragma unroll
    for (int i = 0; i < DQ; ++i) ATT_KLOAD(i);
    ATT_SB();
    if (BIAS) {
#pragma unroll
        for (int t = 0; t < 2 * NSUB; ++t)
#pragma unroll
            for (int r = 0; r < 16; ++r) p[t][r] -= m;
    } else {
#pragma unroll
        for (int t = 0; t < 2 * NSUB; ++t)
#pragma unroll
            for (int r = 0; r < 16; ++r) p[t][r] = -m;
    }
#pragma unroll
    for (int i = DQ; i < NQ + DQ; ++i) {
        if (i < NQ) ATT_KLOAD(i);
        { const int j = i - DQ, s = j / 4, ks = j % 4;
          p[2 * s] = __builtin_amdgcn_mfma_f32_32x32x16_bf16(kb[j % (DQ + 1)][0], qf[ks], p[2 * s], 0, 0, 0);
          p[2 * s + 1] = __builtin_amdgcn_mfma_f32_32x32x16_bf16(kb[j % (DQ + 1)][1], qf[ks], p[2 * s + 1], 0, 0, 0); }
        ATT_SB();
    }
#pragma unroll
    for (int j = 0; j < DP; ++j) ATT_VLOAD(j);
    ATT_SB();
    if (MASK) {
        int dq4 = dq - 4 * hi; asm volatile("" : "+v"(dq4));
#pragma unroll
        for (int r = 0; r < 16; ++r) { const int c = (r & 3) + 8 * (r >> 2); if (c > dq4) p[0][r] = NEG; if (c + 32 > dq4) p[1][r] = NEG; }
    }
    float mx = fmaxf(p[0][0], p[1][0]);
#pragma unroll
    for (int t = 0; t < 2 * NSUB; ++t)
#pragma unroll
        for (int r = 0; r < 16; ++r) mx = fmaxf(mx, p[t][r]);
    mx = max32_f(mx);
    if (__any(mx > THR)) {
        const float d = (mx > THR) ? mx : 0.0f, alpha = __builtin_amdgcn_exp2f(-d);
        m += d; l *= alpha;
#pragma unroll
        for (int db = 0; db < NDB; ++db) o[db] = o[db] * alpha;
#pragma unroll
        for (int t = 0; t < 2 * NSUB; ++t)
#pragma unroll
            for (int r = 0; r < 16; ++r) p[t][r] -= d;
    }
    float s_ = 0.f;
    bf16x8 pbr[2];
    constexpr int NG = NSUB * 4;
#define ATT_EXPACK_ELEM(g_, e_) do { const int t_ = 2 * ((g_) / 4) + (((g_) % 4) >> 1), r_ = 8 * ((g_) & 1) + (e_); p[t_][r_] = __builtin_amdgcn_exp2f(p[t_][r_]); s_ += p[t_][r_]; } while (0)
#pragma unroll
    for (int e2 = 0; e2 < 8; ++e2) ATT_EXPACK_ELEM(0, e2);
    pbr[0] = pack8(p[0], 0);
    ATT_SB();
#pragma unroll
    for (int i = DP; i < NP + DP; ++i) {
        if (i < NP) ATT_VLOAD(i);
        { const int j = i - DP, g = j / NDB, db = j % NDB;
          o[db] = __builtin_amdgcn_mfma_f32_32x32x16_bf16(vbuf[j % (DP + 1)], pbr[g & 1], o[db], 0, 0, 0);
          if (g + 1 < NG) { constexpr int PERG = 8 / NDB;
#pragma unroll
              for (int e2 = 0; e2 < PERG; ++e2) ATT_EXPACK_ELEM(g + 1, db * PERG + e2);
              if (db == NDB - 1) pbr[(g + 1) & 1] = pack8(p[2 * ((g + 1) / 4) + (((g + 1) % 4) >> 1)], (g + 1) & 1); } }
        ATT_SB();
    }
#undef ATT_EXPACK_ELEM
    l += s_;
#undef ATT_KLOAD
#undef ATT_VLOAD
}

__device__ __forceinline__ void fox_unit(Frame& F, KP P, int l, int b, int hf, int qb, const int cbase) {
    const int tid_ = otid();
    const int lane = tid_ & 63, wid = F.wave, r32 = lane & 31, hi = lane >> 5;
    const bf16_t* qkv = (const bf16_t*)(F.ws + WS_QKV); bf16_t* ao = (bf16_t*)(F.ws + WS_ATT);
    const float* ncf = (const float*)(F.ws + WS_CF) + (size_t)(b * 8 + hf) * SEQ;
    const size_t rowbase = (size_t)b * SEQ; const int t0 = qb * 256, NU = 2 * qb + 2, tw = t0 + 32 * wid;
    constexpr int SLOT = 16640;
    bf16x8 qf[4];
    { const bf16_t* Qw = qkv + (rowbase + tw + r32) * NQKV + 1536 + hf * 64;
#pragma unroll
      for (int ks = 0; ks < 4; ++ks) qf[ks] = *(const GAS bf16x8*)(Qw + 16 * ks + 8 * hi); }
    const char* kvbase = (const char*)(qkv + rowbase * NQKV + hf * 64);
    const unsigned koff = (unsigned)((16 * (wid & 3) + (lane & 15)) * NQKV + 2048 + (4 * (wid >> 2) + (lane >> 4)) * 8) * 2u;
    const unsigned vof2 = (unsigned)((16 * (wid & 3) + (lane >> 2)) * NQKV + 2560 + (wid >> 2) * 32 + (lane & 3) * 8) * 2u;
    const unsigned boff = (unsigned)lane * 4u;
    f32x16 o[2], negv; float m = 0.f, lsum = 0.f;
#pragma unroll
    for (int db = 0; db < 2; ++db)
#pragma unroll
        for (int r = 0; r < 16; ++r) { o[db][r] = 0.f; negv[r] = 0.f; }
#define FOX_ISSUE(u) do { _Pragma("unroll") for (int s_ = 0; s_ < 2; ++s_) { const int j_ = 2 * (u) + s_; LAS unsigned char* sl_ = F.lds + (j_ & 3) * SLOT; \
        const char* tb_ = kvbase + (size_t)j_ * 64 * NQKV * 2; dma16(tb_ + koff, sl_ + wid * 1024); dma16(tb_ + vof2, sl_ + 8192 + wid * 1024); if (wid == (j_ & 7)) dma4((const char*)(ncf + j_ * 64) + boff, sl_ + 16384); } } while (0)
    FOX_ISSUE(NU - 1);
    LAS unsigned char* cbuf = F.lds + 4 * SLOT + wid * 8448;
    const bool conv = F.G >= 128; const int nit = (l + 1 < DEPTH) ? CONV_NIT : CONV_NMOE;
    int rprev = -1;
    for (int u = 0; u < NU; ++u) {
        ATT_WAIT_BAR();
        if (u + 1 < NU) FOX_ISSUE(NU - 2 - u);
        if (conv) {
            if (rprev >= 0) { const ConvItem c = conv_decode_ph(P, F.ws, l, rprev); conv_consume(c, cbuf, lane); }
            const int nper = (CONV_NIT + F.G - 1) / F.G, t = ((cbase + u) * 8 + wid) * nper, r = (t / 272) * F.G + F.vcu; rprev = ((t % 272) < nper && r < nit) ? r : -1;
            if (rprev >= 0) { const ConvItem c = conv_decode_ph(P, F.ws, l, rprev); conv_issue(c, cbuf, lane); }
        }
        const int ja = 2 * (NU - 1 - u), jb = ja + 1;
        const LAS char* sa = (const LAS char*)F.lds + (ja & 3) * SLOT; const LAS char* sb = (const LAS char*)F.lds + (jb & 3) * SLOT;
        if (64 * jb + 63 <= tw) tileN<2, 2, true, false>(sa, sa + 8192, (const LAS float*)(sa + 16384), sb, sb + 8192, (const LAS float*)(sb + 16384), qf, o, m, lsum, negv, lane, 0);
        else {
            if (64 * jb <= tw + 31) tileN<1, 2, true, true>(sb, sb + 8192, (const LAS float*)(sb + 16384), sb, sb + 8192, (const LAS float*)(sb + 16384), qf, o, m, lsum, negv, lane, tw + r32 - 64 * jb);
            if (64 * ja + 63 <= tw) tileN<1, 2, true, false>(sa, sa + 8192, (const LAS float*)(sa + 16384), sa, sa + 8192, (const LAS float*)(sa + 16384), qf, o, m, lsum, negv, lane, 0);
            else if (64 * ja <= tw + 31) tileN<1, 2, true, true>(sa, sa + 8192, (const LAS float*)(sa + 16384), sa, sa + 8192, (const LAS float*)(sa + 16384), qf, o, m, lsum, negv, lane, tw + r32 - 64 * ja);
        }
    }
#undef FOX_ISSUE
    if (conv && rprev >= 0) { asm volatile("s_waitcnt vmcnt(0)" ::: "memory"); const ConvItem c = conv_decode_ph(P, F.ws, l, rprev); conv_consume(c, cbuf, lane); }
    const float lt = sum32_f(lsum), inv = 1.0f / lt;
    float ss = 0.f;
#pragma unroll
    for (int db = 0; db < 2; ++db)
#pragma unroll
        for (int r = 0; r < 16; ++r) { o[db][r] *= inv; ss += o[db][r] * o[db][r]; }
    ss = sum32_f(ss);
    const float rn = 1.0f / sqrtf(ss * (1.f / 64.f) + EPS);
    bf16_t* orow = ao + (rowbase + tw + r32) * 1024 + 512 + hf * 64;
#pragma unroll
    for (int db = 0; db < 2; ++db)
#pragma unroll
        for (int g = 0; g < 4; ++g) { const int d0 = db * 32 + 8 * g + 4 * hi; const f32x4 gg = *(const LAS f32x4*)(F.lds + RBT_OFF + d0 * 4);
            u32x2 w; w.x = cvtpk(o[db][4 * g] * rn * gg.x, o[db][4 * g + 1] * rn * gg.y); w.y = cvtpk(o[db][4 * g + 2] * rn * gg.z, o[db][4 * g + 3] * rn * gg.w);
            *(GAS u32x2*)(orow + d0) = w; }
    __syncthreads();
}

__device__ __forceinline__ void diff_unit(Frame& F, KP P, int l, int b, int hd, int qbp, float lam, float osc) {
    const int tid_ = otid();
    const int lane = tid_ & 63, wid = F.wave, r32 = lane & 31, hi = lane >> 5, map = wid >> 2, wq = wid & 3;
    const bf16_t* qkv = (const bf16_t*)(F.ws + WS_QKV); bf16_t* ao = (bf16_t*)(F.ws + WS_ATT);
    const size_t rowbase = (size_t)b * SEQ; const int t0 = qbp * 128, NU = qbp + 1, tw = t0 + 32 * wq, jmax = 2 * qbp + (wq >> 1);
    constexpr int SLOT = 32768;
    bf16x8 qf[4];
    { const bf16_t* Qw = qkv + (rowbase + tw + r32) * NQKV + hd * 128 + map * 64;
#pragma unroll
      for (int ks = 0; ks < 4; ++ks) qf[ks] = *(const GAS bf16x8*)(Qw + 16 * ks + 8 * hi); }
    const char* kvbase = (const char*)(qkv + rowbase * NQKV + hd * 128);
    const unsigned koff = (unsigned)((16 * (wid & 3) + (lane & 15)) * NQKV + 512 + (4 * (wid >> 2) + (lane >> 4)) * 8) * 2u;
    const unsigned vof2 = (unsigned)((16 * (wid & 3) + (lane >> 2)) * NQKV + 1024 + (wid >> 2) * 32 + (lane & 3) * 8) * 2u;
    const int vd = 16384 + (wid >> 2) * 4096 + (wid & 3) * 1024;
    f32x16 o[4], negv; float m = 0.f, lsum = 0.f;
#pragma unroll
    for (int db = 0; db < 4; ++db)
#pragma unroll
        for (int r = 0; r < 16; ++r) { o[db][r] = 0.f; negv[r] = 0.f; }
#define DIFF_ISSUE(u) do { _Pragma("unroll") for (int s_ = 0; s_ < 2; ++s_) { const int j_ = 2 * (u) + s_; LAS unsigned char* sl_ = F.lds + (j_ & 3) * SLOT; const size_t off_ = (size_t)j_ * 64 * NQKV; \
        const char* tb_ = kvbase + off_ * 2; dma16(tb_ + koff, sl_ + wid * 1024); dma16(tb_ + koff + 128, sl_ + 8192 + wid * 1024); dma16(tb_ + vof2, sl_ + vd); dma16(tb_ + vof2 + 128, sl_ + vd + 8192); } } while (0)
    DIFF_ISSUE(0);
    for (int u = 0; u < NU; ++u) {
        ATT_WAIT_BAR();
        if (u + 1 < NU) DIFF_ISSUE(u + 1);
        const int ja = 2 * u, jb = ja + 1;
        const LAS char* sa = (const LAS char*)F.lds + (ja & 3) * SLOT; const LAS char* sb = (const LAS char*)F.lds + (jb & 3) * SLOT;
        if (jb <= jmax) tileN<2, 4, false, false>(sa + map * 8192, sa + 16384, (const LAS float*)sa, sb + map * 8192, sb + 16384, (const LAS float*)sb, qf, o, m, lsum, negv, lane, 0);
        else if (ja <= jmax) tileN<1, 4, false, false>(sa + map * 8192, sa + 16384, (const LAS float*)sa, sa + map * 8192, sa + 16384, (const LAS float*)sa, qf, o, m, lsum, negv, lane, 0);
    }
#undef DIFF_ISSUE
    const float lt = sum32_f(lsum), inv = 1.0f / lt;
    __syncthreads();
    LAS float* X = (LAS float*)F.lds + wq * 4096;
    if (map == 1) {
#pragma unroll
        for (int db = 0; db < 4; ++db)
#pragma unroll
            for (int r = 0; r < 16; ++r) X[(db * 16 + r) * 64 + lane] = o[db][r] * inv;
    }
    __syncthreads();
    if (map == 0) {
        float ss = 0.f;
#pragma unroll
        for (int db = 0; db < 4; ++db)
#pragma unroll
            for (int r = 0; r < 16; ++r) { const float v = o[db][r] * inv - lam * X[(db * 16 + r) * 64 + lane]; o[db][r] = v; ss += v * v; }
        ss = sum32_f(ss);
        const float rn = osc / sqrtf(ss * (1.f / 128.f) + EPS);
        bf16_t* orow = ao + (rowbase + tw + r32) * 1024 + hd * 128;
#pragma unroll
        for (int db = 0; db < 4; ++db)
#pragma unroll
            for (int g = 0; g < 4; ++g) { const int d0 = db * 32 + 8 * g + 4 * hi; const f32x4 gg = *(const LAS f32x4*)(F.lds + RBT_OFF + 256 + d0 * 4);
                u32x2 w; w.x = cvtpk(o[db][4 * g] * rn * gg.x, o[db][4 * g + 1] * rn * gg.y); w.y = cvtpk(o[db][4 * g + 2] * rn * gg.z, o[db][4 * g + 3] * rn * gg.w);
                *(GAS u32x2*)(orow + d0) = w; }
    }
    __syncthreads();
}
}


__device__ __forceinline__ void phase_attn(Frame& F, KP P, const int l) {
    const int ln_ = otid() & 63;
    const float a1 = wave_sum(P->lq1[l * 64 + ln_] * P->lk1[l * 64 + ln_]), a2 = wave_sum(P->lq2[l * 64 + ln_] * P->lk2[l * 64 + ln_]);
    { const int t_ = otid(); LAS float* gl_ = (LAS float*)(F.lds + RBT_OFF); if (t_ < 64) gl_[t_] = P->g_fox[l * 64 + t_]; else if (t_ < 192) gl_[t_] = P->g_subln[l * 128 + t_ - 64]; __syncthreads(); }
    const float linit = (l == 0) ? 0.2f : (l == 1) ? 0.35550906759096934f : (l == 2) ? 0.47071301834358414f : 0.5560582041556406f;
    const float lam = __builtin_bit_cast(float, __builtin_amdgcn_readfirstlane(__builtin_bit_cast(int, expf(a1) - expf(a2) + linit))), osc = __builtin_bit_cast(float, __builtin_amdgcn_readfirstlane((l == 0) ? 0x3f4ccccd : (l == 1) ? 0x3f24fd5c : (l == 2) ? 0x3f077f5a : 0x3ee34c57));
    int cst = 0;
    for (int u = F.vcu; u < 256; u += F.G) {
        { const int bh = u >> 4, p = u & 15; att::diff_unit(F, P, l, bh >> 2, bh & 3, p, lam, osc); att::diff_unit(F, P, l, bh >> 2, bh & 3, 31 - p, lam, osc); }
        { const int bh = u >> 3, p = u & 7; att::fox_unit(F, P, l, bh >> 3, bh & 7, p, cst); att::fox_unit(F, P, l, bh >> 3, bh & 7, 15 - p, cst + 2 * p + 2); cst += 34; }
    }
}

__global__ void __launch_bounds__(512, 2) fwd_kernel(Params P_unused) {
    extern __shared__ __attribute__((aligned(16))) unsigned char lds[];
    Frame F;
    F.lds = (LAS unsigned char*)lds;
    F.MISC = (volatile LAS unsigned*)(F.lds + MISC_OFF);
    F.wave = __builtin_amdgcn_readfirstlane((int)threadIdx.x >> 6);
    F.G = gridDim.x; { const int bx = blockIdx.x; F.vcu = (F.G % 8 == 0) ? (bx % 8) * (F.G / 8) + bx / 8 : bx; }
    const KP kp0 = (KP)__builtin_amdgcn_kernarg_segment_ptr();
#define PP() ({ KP _k = kp0; asm volatile("" : "+s"(_k)); _k; })
    F.ws = kp0->ws; F.ctl = (gu32*)(kp0->ws + WS_CTL);
    for (int u = threadIdx.x; u < 128; u += 512) F.MISC[u] = 0u;
    __syncthreads();
    XcdBarrier bar; bar.bar = (unsigned*)(F.ctl + CW_BAR); bar.x = 0; bar.st = nullptr;
    if (!MK_PER_PHASE) bar = xcd_barrier_post((unsigned*)(F.ctl + CW_BAR), F.MISC + 8);
    const int lo = kp0->ph_lo, hi = kp0->ph_hi;
#define IN(k) (lo <= (k) && (k) < hi)
#define SEAM(k) do { if (!MK_PER_PHASE && IN((k) + 1)) xcd_barrier(bar); } while (0)

    if (IN(0)) { p0_prologue(F, PP()); SEAM(0); }
    for (int l = 0; l < DEPTH; ++l) {
        const int pb = 1 + NPH_LAYER * l;
        const float* mod = (const float*)(F.ws + WS_MOD);
        if (IN(pb + 0)) { phase_norm1(F, PP(), l); SEAM(pb + 0); }
        if (IN(pb + 1)) {
            if (F.vcu < 32) scan_item(F, F.vcu);
            for (int s = F.vcu + F.G; s < 32; s += F.G) scan_item(F, s);
            pg8::DenseSched S; S.init(NTOK, NQKV, DM, F.G, (int)blockIdx.x, F.ws + WS_H, F.ws + WS_WIN + (size_t)l * NQKV * DM * 2);
            EpiQKV E{(bf16_t*)(F.ws + WS_QKV), (const float*)(F.ws + WS_ROPE)};
            pg8::gemm_phase<EpiQKV, pg8::DenseSched, true>(F.lds, (const char*)(F.ws + WS_H), DM, S, E);
            SEAM(pb + 1);
        }
        if (IN(pb + 2)) { phase_attn(F, PP(), l); SEAM(pb + 2); }
        if (IN(pb + 3)) {
            pg8::DenseSched S; S.init(NTOK, DM, DM, F.G, (int)blockIdx.x, F.ws + WS_ATT, F.ws + WS_WOUT + (size_t)l * DM * DM * 2);
            EpiRes E{(bf16_t*)(F.ws + WS_X), mod + (size_t)l * 4 * 6144 + 2 * 1024};
            pg8::gemm_phase<EpiRes, pg8::DenseSched, true>(F.lds, (const char*)(F.ws + WS_ATT), DM, S, E);
            SEAM(pb + 3);
        }
        if (IN(pb + 4)) { phase_router(F, PP(), l); SEAM(pb + 4); }
        if (IN(pb + 5)) {
            MoeSched<true> S; moe_tables<true, false>(F, l, S); S.K = DM; S.A = (const char*)(F.ws + WS_H); S.Bt = (const char*)(F.ws + WS_WGU + (size_t)l * NEXP * 1024 * 1024 * 2); S.bstride = (size_t)1024 * 1024 * 2;
            EpiGU E{(bf16_t*)(F.ws + WS_ACT)};
            pg8::gemm_phase<EpiGU, MoeSched<true>, true>(F.lds, (const char*)(F.ws + WS_H), DM, S, E);
            SEAM(pb + 5);
        }
        if (IN(pb + 6)) {
            MoeSched<false> S; moe_tables<false, !MK_PER_PHASE>(F, l, S); S.K = DEXP; S.A = (const char*)(F.ws + WS_ACT); S.Bt = (const char*)(F.ws + WS_WD + (size_t)l * NEXP * 1024 * 512 * 2); S.bstride = (size_t)1024 * 512 * 2;
            EpiDown E{(bf16_t*)(F.ws + WS_YS), (const LAS int*)(F.lds + TENT_OFF), (const LAS float*)(F.lds + TAB_OFF + MAXU * 1024)};
            pg8::gemm_phase<EpiDown, MoeSched<false>, true>(F.lds, (const char*)(F.ws + WS_ACT), DEXP, S, E);
            SEAM(pb + 6);
        }
    }
    { KP q_ = PP(); if (q_->ph_lo <= NPHASES - 1 && NPHASES - 1 < q_->ph_hi) phase_norm1(F, q_, DEPTH); }
#undef IN
#undef SEAM
}

extern "C" void kernel_launch(void* const* d_in, const int* in_sizes, int n_in, void* d_out, int out_size, void* d_ws, size_t ws_size, hipStream_t stream) {
    static int grid = 0;
    if (grid == 0) {
        if (n_in != 24 || out_size != NTOK * DM || ws_size < WS_END) { fprintf(stderr, "kernel_launch: unexpected problem (n_in %d, out %d, ws %zu); nothing launched\n", n_in, out_size, ws_size); grid = -1; return; }
        int dev = 0, cus = 0, per_cu = 0;
        if (hipGetDevice(&dev) != hipSuccess || hipDeviceGetAttribute(&cus, hipDeviceAttributeMultiprocessorCount, dev) != hipSuccess) { grid = -1; return; }
        if (hipFuncSetAttribute((const void*)fwd_kernel, hipFuncAttributeMaxDynamicSharedMemorySize, LDS_BYTES) != hipSuccess) { fprintf(stderr, "kernel_launch: hipFuncSetAttribute failed\n"); grid = -1; return; }
        if (hipOccupancyMaxActiveBlocksPerMultiprocessor(&per_cu, (const void*)fwd_kernel, 512, LDS_BYTES) != hipSuccess || per_cu < 1) { fprintf(stderr, "kernel_launch: occupancy query reports %d blocks per CU\n", per_cu); }
        (void)hipGetLastError();
        grid = cus;
        if (grid > 256) grid = 256;
    }
    if (grid < 0) return;
    (void)hipMemsetAsync((char*)d_ws + WS_CTL, 0, CTL_ZERO_BYTES, stream);
    Params p{};
    p.x = (const float*)d_in[0]; p.c = (const float*)d_in[1]; p.pos = (const int*)d_in[2]; p.w_ada = (const float*)d_in[3]; p.b_ada = (const float*)d_in[4]; p.g_mix = (const float*)d_in[5];
    p.w_in = (const float*)d_in[6]; p.b_forget = (const float*)d_in[7]; p.lq1 = (const float*)d_in[8]; p.lk1 = (const float*)d_in[9]; p.lq2 = (const float*)d_in[10]; p.lk2 = (const float*)d_in[11];
    p.g_subln = (const float*)d_in[12]; p.g_fox = (const float*)d_in[13]; p.w_out = (const float*)d_in[14]; p.g_ffn = (const float*)d_in[15]; p.wrg = (const float*)d_in[16]; p.brg = (const float*)d_in[17];
    p.wre = (const float*)d_in[18]; p.bre = (const float*)d_in[19]; p.wg = (const float*)d_in[20]; p.wu = (const float*)d_in[21]; p.wd = (const float*)d_in[22]; p.g_final = (const float*)d_in[23];
    p.out = (float*)d_out; p.ws = (unsigned char*)d_ws;
#if MK_PER_PHASE
    for (int ph = 0; ph < NPHASES; ++ph) { p.ph_lo = ph; p.ph_hi = ph + 1; hipLaunchKernelGGL(fwd_kernel, dim3(grid), dim3(512), LDS_BYTES, stream, p);
    }
#else
    p.ph_lo = 0; p.ph_hi = NPHASES;
    hipLaunchKernelGGL(fwd_kernel, dim3(grid), dim3(512), LDS_BYTES, stream, p);
#endif
    const hipError_t le = hipPeekAtLastError();
    if (le != hipSuccess) fprintf(stderr, "kernel_launch: launch failed: %s\n", hipGetErrorName(le));
}
```

```cpp
#include <hip/hip_runtime.h>
#include <cstdio>
#include <cstdint>

#ifndef MK_PER_PHASE
#define MK_PER_PHASE 0
#endif

#define GAS __attribute__((address_space(1)))
#define LAS __attribute__((address_space(3)))
typedef unsigned short bf16_t;
typedef short bf16x8 __attribute__((ext_vector_type(8)));
typedef short s16x4 __attribute__((ext_vector_type(4)));
typedef float f32x4 __attribute__((ext_vector_type(4)));
typedef float f32x2 __attribute__((ext_vector_type(2)));
typedef float f32x16 __attribute__((ext_vector_type(16)));
typedef unsigned u32x4 __attribute__((ext_vector_type(4)));
typedef unsigned u32x2 __attribute__((ext_vector_type(2)));
typedef GAS unsigned gu32;

constexpr int DM = 1024, NB_ = 4, SEQ = 4096, DEPTH = 4, NTOK = NB_ * SEQ;
constexpr int INC = 3080, NQKV = 3072;
constexpr int NEXP = 32, DEXP = 512;
constexpr float EPS = 1e-6f;
constexpr float C2 = 0.125f * 1.4426950408889634f;
constexpr float LOG2E = 1.4426950408889634f;
constexpr int NPH_LAYER = 7, NPHASES = 2 + NPH_LAYER * DEPTH;

constexpr size_t MiB = 1u << 20;
constexpr size_t WS_CTL = 0, CTL_ZERO_BYTES = 1 * MiB;
constexpr size_t WS_MOD = 1 * MiB;
constexpr size_t WS_ROPE = 2 * MiB;
constexpr size_t WS_WINF = 3 * MiB;
constexpr size_t WS_WRT = 4 * MiB;
constexpr size_t WS_LF = 5 * MiB;
constexpr size_t WS_CF = 6 * MiB;
constexpr size_t WS_LIST = 8 * MiB;
constexpr size_t WS_WLIST = 10 * MiB;
constexpr size_t WS_WIN = 16 * MiB;
constexpr size_t WS_WOUT = 40 * MiB;
constexpr size_t WS_WGU = 48 * MiB;
constexpr size_t WS_WD = 304 * MiB;
constexpr size_t WS_H = 432 * MiB;
constexpr size_t WS_QKV = 464 * MiB;
constexpr size_t WS_ATT = 560 * MiB;
constexpr size_t WS_ACT = 592 * MiB;
constexpr size_t WS_YS = 632 * MiB;
constexpr size_t WS_X = 696 * MiB;
constexpr size_t WS_END = 728 * MiB;
constexpr int CW_BAR = 4096;
constexpr int CW_CNT = 16384;

constexpr int RING_BYTES = 131072;
constexpr int TAB_OFF = RING_BYTES;
constexpr int RBT_OFF = TAB_OFF + 16384;
constexpr int MISC_OFF = RBT_OFF + 2048;
constexpr int TENT_OFF = MISC_OFF + 512;
constexpr int LDS_BYTES = TENT_OFF + 8192;

#define RLX_AGENT __ATOMIC_RELAXED, __HIP_MEMORY_SCOPE_AGENT
#define LDS_WAIT() asm volatile("s_waitcnt lgkmcnt(0)" ::: "memory")
#define VM_WAIT() asm volatile("s_waitcnt vmcnt(0)" ::: "memory")
__device__ __forceinline__ unsigned f2bf(float f) { unsigned u = __builtin_bit_cast(unsigned, f); return (u + 0x7fffu + ((u >> 16) & 1u)) >> 16; }
__device__ __forceinline__ unsigned pk2(float lo, float hi) { return f2bf(lo) | (f2bf(hi) << 16); }
__device__ __forceinline__ float bflo(unsigned u) { return __builtin_bit_cast(float, u << 16); }
__device__ __forceinline__ float bfhi(unsigned u) { return __builtin_bit_cast(float, u & 0xffff0000u); }
typedef __bf16 bf16x2_t __attribute__((ext_vector_type(2)));
__device__ __forceinline__ unsigned cvtpk(float lo, float hi) { f32x2 v = {lo, hi}; bf16x2_t b = __builtin_convertvector(v, bf16x2_t); return __builtin_bit_cast(unsigned, b); }
template <int CTRL> __device__ __forceinline__ float dpp_f(float v) { return __builtin_bit_cast(float, __builtin_amdgcn_update_dpp(0, __builtin_bit_cast(int, v), CTRL, 0xF, 0xF, true)); }
__device__ __forceinline__ float xor16_f(float v) { return __builtin_bit_cast(float, __builtin_amdgcn_ds_swizzle(__builtin_bit_cast(int, v), 0x401F)); }
__device__ __forceinline__ float swap32_f(float v) { return __shfl_xor(v, 32); }
__device__ __forceinline__ float sum32_f(float v) { return v + swap32_f(v); }
__device__ __forceinline__ float max32_f(float v) { return fmaxf(v, swap32_f(v)); }
__device__ __forceinline__ float wave_sum(float v) {
    v += dpp_f<0xB1>(v);
    v += dpp_f<0x4E>(v);
    v += dpp_f<0x141>(v);
    v += dpp_f<0x140>(v);
    v += __builtin_bit_cast(float, __builtin_amdgcn_update_dpp(0, __builtin_bit_cast(int, v), 0x142, 0xA, 0xF, false));
    v += __builtin_bit_cast(float, __builtin_amdgcn_update_dpp(0, __builtin_bit_cast(int, v), 0x143, 0xC, 0xF, false));
    return __builtin_bit_cast(float, __builtin_amdgcn_readlane(__builtin_bit_cast(int, v), 63));
}
__device__ __forceinline__ int otid() { int t = threadIdx.x; asm volatile("" : "+v"(t)); return t; }
__device__ __forceinline__ unsigned ld_agent(const unsigned* p) { return __hip_atomic_load(p, __ATOMIC_RELAXED, __HIP_MEMORY_SCOPE_AGENT); }

#define XB_TMO      128
#define XB_XCNT(j)  (256  + 64 * (j))
#define XB_XSUB(j)  (1280 + 64 * (j))
#define XB_XGEN(j)  (2304 + 64 * (j))
#define XB_TOP      3328
#define XB_TOPGEN   3392
#define XCD_BAR_WORDS 3456
#define XB_SPIN_CAP (1u << 18)
__device__ __forceinline__ unsigned xb_ld(unsigned* p)              { return __hip_atomic_load(p, __ATOMIC_RELAXED, __HIP_MEMORY_SCOPE_AGENT); }
__device__ __forceinline__ unsigned xb_add(unsigned* p, unsigned v) { return __hip_atomic_fetch_add(p, v, __ATOMIC_RELAXED, __HIP_MEMORY_SCOPE_AGENT); }
__device__ __forceinline__ unsigned xb_xcc_id() { return (unsigned)__builtin_amdgcn_s_getreg((3 << 11) | 20) & 0xFu; }
#define XB_SPIN(cond, bar) do { unsigned _sp = 0; while (cond) { __builtin_amdgcn_s_sleep(1); \
    if ((++_sp & 255u) == 0u) { if (xb_ld(&(bar)[XB_TMO])) break; if (_sp > XB_SPIN_CAP) { atomicAdd(&(bar)[XB_TMO], 1u); break; } } } } while (0)
struct XcdBarrier { unsigned* bar; unsigned x; volatile LAS unsigned* st; };
__device__ __forceinline__ XcdBarrier xcd_barrier_post(unsigned* bar, volatile LAS unsigned* st) {
    XcdBarrier b; b.bar = bar; b.x = xb_xcc_id(); b.st = st;
    if (threadIdx.x == 0) (void)xb_add(&bar[XB_XCNT(b.x)], 1u);
    return b;
}
__device__ __forceinline__ void xcd_barrier_complete(unsigned* bar, unsigned x, unsigned& nloc, unsigned& nx) {
    const unsigned G = gridDim.x * gridDim.y * gridDim.z;
    unsigned sum, cnt, mine, sp = 0u;
    for (;;) {
        sum = 0u; cnt = 0u; mine = 0u;
#pragma unroll
        for (unsigned j = 0; j < 16; ++j) { const unsigned c = xb_ld(&bar[XB_XCNT(j)]); sum += c; cnt += (c > 0u) ? 1u : 0u; mine = (j == x) ? c : mine; }
        if (sum == G) break;
        __builtin_amdgcn_s_sleep(1);
        if ((++sp & 255u) == 0u) { if (xb_ld(&bar[XB_TMO])) break; if (sp > XB_SPIN_CAP) { atomicAdd(&bar[XB_TMO], 1u); break; } }
    }
    nloc = mine > 0u ? mine : 1u; nx = cnt > 0u ? cnt : 1u;
}
__device__ __forceinline__ void xcd_barrier(const XcdBarrier& b) {
    asm volatile("s_waitcnt vmcnt(0)" ::: "memory");
    __syncthreads();
    if (threadIdx.x == 0) {
        unsigned* bar = b.bar;
        __builtin_amdgcn_s_waitcnt(0);
        unsigned nloc = b.st[0], nx = b.st[1];
        if (nloc == 0u) { xcd_barrier_complete(bar, b.x, nloc, nx); b.st[0] = nloc; b.st[1] = nx; }
        const unsigned old = xb_add(&bar[XB_XSUB(b.x)], 1u);
        const unsigned gen = old / nloc;
        if (old + 1u == (gen + 1u) * nloc) {
            __builtin_amdgcn_fence(__ATOMIC_RELEASE, "agent");
            asm volatile("s_waitcnt vmcnt(0)" ::: "memory");
            const unsigned og = xb_add(&bar[XB_TOP], 1u);
            const unsigned tg = og / nx;
            if (og + 1u == (tg + 1u) * nx) xb_add(&bar[XB_TOPGEN], 1u);
            else XB_SPIN(xb_ld(&bar[XB_TOPGEN]) == tg, bar);
            __builtin_amdgcn_fence(__ATOMIC_ACQUIRE, "agent");
            xb_add(&bar[XB_XGEN(b.x)], 1u);
            asm volatile("s_waitcnt vmcnt(0)" ::: "memory");
        } else {
            XB_SPIN(xb_ld(&bar[XB_XGEN(b.x)]) == gen, bar);
            __builtin_amdgcn_fence(__ATOMIC_ACQUIRE, "agent");
            asm volatile("s_waitcnt vmcnt(0)" ::: "memory");
        }
    }
    __syncthreads();
}

namespace pg8 {
constexpr int BM = 256, BK = 64, HALF = 128, HTB = HALF * BK * 2, STAGE_BYTES = 8 * HTB, NXCD = 8, WGM = 8;
__host__ __device__ __forceinline__ int lds_byte(int r, int c) { const int st = (r >> 4) * 2 + (c >> 5), rr = r & 15, cc = c & 31, ob = rr * 64 + cc * 2; return st * 1024 + (ob ^ (((ob >> 9) & 1) << 5)); }
__host__ __device__ __forceinline__ void stage_rc(int b, int& R, int& C) { const int st = b / 1024, sb = b % 1024, swz = sb ^ (((sb >> 9) & 1) << 5); R = (st >> 1) * 16 + swz / 64; C = (st & 1) * 32 + (swz % 64) / 2; }
__host__ __device__ __forceinline__ int perm32(int rho) { const int n = rho >> 4, i = rho & 15; return 8 * (i >> 2) + 4 * n + (i & 3); }

struct Unit { int pm, pn, e, slot; };

template <class Epi, class Sched, bool ALIGN_EPI = true>
__device__ __forceinline__ void gemm_phase(LAS unsigned char* lds, const char* Abase, const int K, const Sched& S, const Epi& E) {
    constexpr bool GATHER = Sched::GATHER;
    const int tid_ = otid();
    const int tid = tid_, wid = __builtin_amdgcn_readfirstlane(tid >> 6), lane = tid & 63, wr = wid >> 2, wc = wid & 3, fr = lane & 15, fq = lane >> 4;
    const int nt = K / BK;
    int Ri[2]; unsigned Ci2[2], voffA[2], voffB[2];
#pragma unroll
    for (int i = 0; i < 2; ++i) { int R, C; stage_rc(tid * 16 + i * 8192, R, C); const int Rb = (R & ~31) + perm32(R & 31);
        Ri[i] = R; Ci2[i] = (unsigned)C * 2u; voffA[i] = (unsigned)(R * K + C) * 2u; voffB[i] = (unsigned)(Rb * K + C) * 2u; }
    const size_t kstep = (size_t)(BK * 2);
    const size_t hstep = (size_t)HALF * K * 2;
    const unsigned ldsw = (unsigned)wid * 1024u;
    const int aoff = lds_byte(wr * 64 + fr, fq * 8), boff = lds_byte(wc * 32 + fr, fq * 8);
#define PG8_SA(b, h) (((b) * 2 + (h)) * HTB)
#define PG8_SB(b, h) ((4 + (b) * 2 + (h)) * HTB)
#define PG8_STAGE_B(bufoff, gbase) do { _Pragma("unroll") for (int _i = 0; _i < 2; ++_i) \
        __builtin_amdgcn_global_load_lds((const unsigned*)((const char*)(gbase) + voffB[_i]), (LAS unsigned*)(lds + (bufoff) + ldsw + _i * 8192), 16, 0, 0); } while (0)
#define PG8_STAGE_A(bufoff, uptr, us, h, koff) do { if constexpr (GATHER) { _Pragma("unroll") for (int _i = 0; _i < 2; ++_i) { const unsigned _vo = S.toff[(us) * 256 + (h) * HALF + Ri[_i]] + Ci2[_i]; \
            __builtin_amdgcn_global_load_lds((const unsigned*)(Abase + (koff) + _vo), (LAS unsigned*)(lds + (bufoff) + ldsw + _i * 8192), 16, 0, 0); } } \
        else { _Pragma("unroll") for (int _i = 0; _i < 2; ++_i) \
            __builtin_amdgcn_global_load_lds((const unsigned*)((uptr) + (size_t)(h) * hstep + (koff) + voffA[_i]), (LAS unsigned*)(lds + (bufoff) + ldsw + _i * 8192), 16, 0, 0); } } while (0)
#define PG8_LDA(dst, b, h) do { _Pragma("unroll") for (int m = 0; m < 4; ++m) _Pragma("unroll") for (int k = 0; k < 2; ++k) dst[m][k] = *(const LAS bf16x8*)(lds + PG8_SA(b, h) + aoff + m * 2048 + k * 1024); } while (0)
#define PG8_LDB(dst, b, h) do { _Pragma("unroll") for (int n = 0; n < 2; ++n) _Pragma("unroll") for (int k = 0; k < 2; ++k) dst[n][k] = *(const LAS bf16x8*)(lds + PG8_SB(b, h) + boff + n * 2048 + k * 1024); } while (0)
#define PG8_MMA(ai, bj, At, Bt) do { __builtin_amdgcn_s_setprio(1); _Pragma("unroll") for (int m = 0; m < 4; ++m) _Pragma("unroll") for (int n = 0; n < 2; ++n) _Pragma("unroll") for (int k = 0; k < 2; ++k) \
        acc[ai][bj][m][n] = __builtin_amdgcn_mfma_f32_16x16x32_bf16(Bt[n][k], At[m][k], acc[ai][bj][m][n], 0, 0, 0); __builtin_amdgcn_s_setprio(0); } while (0)
#define PG8_WAIT_V(n) asm volatile("s_waitcnt vmcnt(" #n ")" ::: "memory")
#define PG8_WAIT_L(n) asm volatile("s_waitcnt lgkmcnt(" #n ")" ::: "memory")
#define PG8_BAR __builtin_amdgcn_s_barrier()
#define PG8_SCHED __builtin_amdgcn_sched_barrier(0)
    Unit cur, nxt; int ui = 0;
    if (!S.next(0, cur)) return;
    f32x4 acc[2][2][4][2];
#pragma unroll
    for (int a = 0; a < 2; ++a)
#pragma unroll
        for (int b = 0; b < 2; ++b)
#pragma unroll
            for (int m = 0; m < 4; ++m)
#pragma unroll
                for (int n = 0; n < 2; ++n) acc[a][b][m][n] = (f32x4){0.f, 0.f, 0.f, 0.f};
    bf16x8 At[4][2], B0[2][2], B1[2][2];
    const char* cA = S.aptr(cur); const char* cB = S.bptr(cur);
    PG8_STAGE_B(PG8_SB(0, 0), cB); PG8_STAGE_B(PG8_SB(0, 1), cB + hstep); PG8_STAGE_A(PG8_SA(0, 0), cA, cur.slot, 0, 0); PG8_STAGE_A(PG8_SA(0, 1), cA, cur.slot, 1, 0);
    if (wr == 1) PG8_BAR;
    PG8_WAIT_V(2); PG8_BAR;
    PG8_STAGE_B(PG8_SB(1, 0), cB + kstep); PG8_STAGE_A(PG8_SA(1, 0), cA, cur.slot, 0, kstep); PG8_STAGE_B(PG8_SB(1, 1), cB + hstep + kstep);
    PG8_WAIT_V(6); PG8_BAR;
    for (;;) {
        const bool has_next = S.next(ui + 1, nxt);
        const char* nA = has_next ? S.aptr(nxt) : cA; const char* nB = has_next ? S.bptr(nxt) : cB; const int nslot = has_next ? nxt.slot : cur.slot;
        for (int t = 0; t < nt; t += 2) {
            const bool last = (t == nt - 2);
            const size_t k1 = (size_t)(t + 1) * kstep;
            const size_t k2 = last ? (size_t)0 : (size_t)(t + 2) * kstep, k3 = k2 + kstep;
            const char* a2 = last ? nA : cA; const int s2 = last ? nslot : cur.slot;
            const char* b2 = last ? nB : cB + (size_t)(t + 2) * kstep; const char* b3 = b2 + kstep;
            PG8_LDB(B0, 0, 0); PG8_LDB(B1, 0, 1); PG8_SCHED; PG8_LDA(At, 0, 0); PG8_STAGE_A(PG8_SA(1, 1), cA, cur.slot, 1, k1);
            PG8_WAIT_V(8); PG8_WAIT_L(0); PG8_BAR; PG8_MMA(0, 0, At, B0); PG8_MMA(0, 1, At, B1); PG8_BAR; PG8_SCHED;
            PG8_LDA(At, 0, 1); PG8_STAGE_B(PG8_SB(0, 0), b2); PG8_STAGE_B(PG8_SB(0, 1), b2 + hstep); PG8_STAGE_A(PG8_SA(0, 0), a2, s2, 0, k2);
            PG8_WAIT_V(8); PG8_WAIT_L(0); PG8_BAR; PG8_MMA(1, 0, At, B0); PG8_MMA(1, 1, At, B1); PG8_BAR; PG8_SCHED;
            PG8_LDB(B0, 1, 0); PG8_LDB(B1, 1, 1); PG8_SCHED; PG8_LDA(At, 1, 0); PG8_STAGE_A(PG8_SA(0, 1), a2, s2, 1, k2);
            PG8_WAIT_V(8); PG8_WAIT_L(0); PG8_BAR; PG8_MMA(0, 0, At, B0); PG8_MMA(0, 1, At, B1); PG8_BAR; PG8_SCHED;
            PG8_LDA(At, 1, 1); PG8_STAGE_B(PG8_SB(1, 0), b3); PG8_STAGE_B(PG8_SB(1, 1), b3 + hstep); PG8_STAGE_A(PG8_SA(1, 0), a2, s2, 0, k3);
            PG8_WAIT_V(8); PG8_WAIT_L(0); PG8_BAR; PG8_MMA(1, 0, At, B0); PG8_MMA(1, 1, At, B1); PG8_BAR; PG8_SCHED;
        }
        if constexpr (ALIGN_EPI) { if (wr == 0) PG8_BAR; }
        E(acc, cur, wr, wc, fr, fq);
        if (!has_next) break;
#pragma unroll
        for (int a = 0; a < 2; ++a)
#pragma unroll
            for (int b = 0; b < 2; ++b)
#pragma unroll
                for (int m = 0; m < 4; ++m)
#pragma unroll
                    for (int n = 0; n < 2; ++n) acc[a][b][m][n] = (f32x4){0.f, 0.f, 0.f, 0.f};
        cur = nxt; cA = nA; cB = nB; ++ui;
        if constexpr (ALIGN_EPI) { if (wr == 1) PG8_BAR; }
    }
    PG8_WAIT_V(0);
    if constexpr (!ALIGN_EPI) { if (wr == 0) PG8_BAR; }
    PG8_BAR;
#undef PG8_SA
#undef PG8_SB
#undef PG8_STAGE_A
#undef PG8_STAGE_B
#undef PG8_LDA
#undef PG8_LDB
#undef PG8_MMA
#undef PG8_WAIT_V
#undef PG8_WAIT_L
#undef PG8_BAR
#undef PG8_SCHED
}

struct DenseSched {
    static constexpr bool GATHER = false;
    int nM, nN, nwg, G, c, K; const char* A; const char* Bt; const LAS unsigned* toff;
    __device__ void init(int M, int N, int K_, int G_, int c_, const void* A_, const void* Bt_) { nM = M / BM; nN = N / BM; nwg = nM * nN; G = G_; c = c_; K = K_; A = (const char*)A_; Bt = (const char*)Bt_; toff = nullptr; }
    __device__ __forceinline__ bool next(int i, Unit& u) const {
        const long L = (long)i * G + c; if (L >= nwg) return false;
        int wgid = (int)L; { const int q = nwg / NXCD, r = nwg % NXCD, xcd = wgid % NXCD, off = wgid / NXCD; wgid = (xcd < r ? xcd * (q + 1) : r * (q + 1) + (xcd - r) * q) + off; }
        const int nig = WGM * nN, gid = wgid / nig, fm = gid * WGM, gsz = (nM - fm) < WGM ? (nM - fm) : WGM;
        u.pm = fm + ((wgid % nig) % gsz); u.pn = (wgid % nig) / gsz; u.e = 0; u.slot = i; return true;
    }
    __device__ __forceinline__ const char* aptr(const Unit& u) const { return A + (size_t)u.pm * BM * K * 2; }
    __device__ __forceinline__ const char* bptr(const Unit& u) const { return Bt + (size_t)u.pn * BM * K * 2; }
};
}

struct Params {
    const float* x; const float* c; const int* pos; const float* w_ada; const float* b_ada; const float* g_mix; const float* w_in; const float* b_forget;
    const float* lq1; const float* lk1; const float* lq2; const float* lk2; const float* g_subln; const float* g_fox; const float* w_out; const float* g_ffn;
    const float* wrg; const float* brg; const float* wre; const float* bre; const float* wg; const float* wu; const float* wd; const float* g_final;
    float* out; unsigned char* ws; int ph_lo, ph_hi;
};
typedef const __attribute__((address_space(4))) Params* KP;
struct Frame {
    LAS unsigned char* lds;
    volatile LAS unsigned* MISC;
    gu32* ctl;
    int wave, vcu, G;
    unsigned char* ws;
};

constexpr int CONV_NIT = 16 * 96 + 16 * 32 + 3 * NEXP * 256;
struct ConvItem { const float* W; bf16_t* WT; int ldw, K, k0, n0, drow0; };
__device__ __forceinline__ ConvItem conv_decode(KP P, unsigned char* ws, int l, int r) {
    ConvItem c;
    if (r < 1536) { const int kb = r / 96, nb = r % 96; c.W = P->w_in + (size_t)l * 1024 * INC; c.ldw = INC; c.K = 1024; c.WT = (bf16_t*)(ws + WS_WIN) + (size_t)l * NQKV * 1024; c.k0 = 64 * kb; c.n0 = 32 * nb; c.drow0 = 32 * nb; return c; }
    r -= 1536;
    if (r < 512) { const int kb = r / 32, nb = r % 32; c.W = P->w_out + (size_t)l * 1024 * 1024; c.ldw = 1024; c.K = 1024; c.WT = (bf16_t*)(ws + WS_WOUT) + (size_t)l * 1024 * 1024; c.k0 = 64 * kb; c.n0 = 32 * nb; c.drow0 = 32 * nb; return c; }
    r -= 512;
    if (r < 2 * NEXP * 256) { const int up = r >= NEXP * 256; if (up) r -= NEXP * 256; const int le = l * NEXP + r / 256, q = r % 256, kb = q / 16, nb = q % 16, n0 = 32 * nb;
        c.W = (up ? P->wu : P->wg) + (size_t)le * 1024 * 512; c.ldw = 512; c.K = 1024; c.WT = (bf16_t*)(ws + WS_WGU) + (size_t)le * 1024 * 1024; c.k0 = 64 * kb; c.n0 = n0; c.drow0 = (n0 >> 7) * 256 + (n0 & 127) + (up ? 128 : 0); return c; }
    r -= 2 * NEXP * 256;
    { const int le = l * NEXP + r / 256, q = r % 256, kb = q / 32, nb = q % 32; c.W = P->wd + (size_t)le * 512 * 1024; c.ldw = 1024; c.K = 512; c.WT = (bf16_t*)(ws + WS_WD) + (size_t)le * 1024 * 512; c.k0 = 64 * kb; c.n0 = 32 * nb; c.drow0 = 32 * nb; }
    return c;
}
constexpr int CONV_NMOE = 3 * NEXP * 256, CONV_NDENSE = 16 * 96 + 16 * 32;
__device__ __forceinline__ ConvItem conv_decode_ph(KP P, unsigned char* ws, int l, int r) { return (r < CONV_NMOE) ? conv_decode(P, ws, l, r + CONV_NDENSE) : conv_decode(P, ws, l + 1, r - CONV_NMOE); }
__device__ __forceinline__ void conv_issue(const ConvItem& c, LAS unsigned char* buf, int lane) {
    const unsigned lo = (unsigned)((lane >> 3) * c.ldw + (lane & 7) * 4) * 4u;
    const char* base = (const char*)(c.W + (size_t)c.k0 * c.ldw + c.n0);
#pragma unroll
    for (int i = 0; i < 8; ++i) __builtin_amdgcn_global_load_lds((const unsigned*)(base + (size_t)i * 8 * c.ldw * 4 + lo), (LAS unsigned*)(buf + i * 1056), 16, 0, 2);
}
__device__ __forceinline__ void conv_consume(const ConvItem& c, const LAS unsigned char* buf, int lane) {
    const LAS float* s = (const LAS float*)buf + (lane & 7) * 264 + (lane >> 3);
    bf16_t* d = c.WT + (size_t)(c.drow0 + (lane >> 3)) * c.K + c.k0 + (lane & 7) * 8;
#pragma unroll
    for (int j = 0; j < 4; ++j) { u32x4 o; o.x = cvtpk(s[8 * j], s[8 * j + 32]); o.y = cvtpk(s[8 * j + 64], s[8 * j + 96]); o.z = cvtpk(s[8 * j + 128], s[8 * j + 160]); o.w = cvtpk(s[8 * j + 192], s[8 * j + 224]);
        __builtin_nontemporal_store(o, (GAS u32x4*)(d + (size_t)(8 * j) * c.K)); asm volatile("" ::: "memory"); }
}

__device__ __forceinline__ void p0_transpose_item(const float* W, int ldw, int K, bf16_t* WT, int k0, int n0, int drow0, LAS float* scr, int lane) {
#pragma unroll 8
    for (int i = 0; i < 32; ++i) { const int kk = 2 * i + (lane >> 5); scr[kk * 33 + (lane & 31)] = __builtin_nontemporal_load(W + (size_t)(k0 + kk) * ldw + n0 + (lane & 31)); }
    LDS_WAIT(); asm volatile("" ::: "memory");
    const int c = lane & 7;
#pragma unroll
    for (int j = 0; j < 4; ++j) { const int n = (lane >> 3) + 8 * j; const LAS float* s = scr + (8 * c) * 33 + n;
        u32x4 o; o.x = pk2(s[0 * 33], s[1 * 33]); o.y = pk2(s[2 * 33], s[3 * 33]); o.z = pk2(s[4 * 33], s[5 * 33]); o.w = pk2(s[6 * 33], s[7 * 33]);
        __builtin_nontemporal_store(o, (GAS u32x4*)(WT + (size_t)(drow0 + n) * K + k0 + 8 * c)); }
    LDS_WAIT(); asm volatile("" ::: "memory");
}
__device__ __forceinline__ void sincos_d(double a, double& s, double& c) {
    const double TWO_OVER_PI = 0.63661977236758134308, PIO2_H = 1.57079632673412561417e+00, PIO2_L = 6.07710050650619224932e-11;
    const double kq = __builtin_rint(a * TWO_OVER_PI);
    double r = (a - kq * PIO2_H) - kq * PIO2_L;
    const int q = ((int)kq) & 3;
    const double r2 = r * r;
    double sp = -7.6471637318198164759e-13;
    sp = sp * r2 + 1.6059043836821614599e-10; sp = sp * r2 - 2.5052108385441718775e-08; sp = sp * r2 + 2.7557319223985890653e-06; sp = sp * r2 - 1.9841269841269841270e-04;
    sp = sp * r2 + 8.3333333333333333333e-03; sp = sp * r2 - 1.6666666666666666667e-01; const double sr = r + r * r2 * sp;
    double cp = 4.7794773323873852974e-14;
    cp = cp * r2 - 1.1470745597729724714e-11; cp = cp * r2 + 2.0876756987868098979e-09; cp = cp * r2 - 2.7557319223985890653e-07; cp = cp * r2 + 2.4801587301587301587e-05;
    cp = cp * r2 - 1.3888888888888888889e-03; cp = cp * r2 + 4.1666666666666666667e-02; cp = cp * r2 - 0.5; const double cr = 1.0 + r2 * cp;
    s = (q == 0) ? sr : (q == 1) ? cr : (q == 2) ? -sr : -cr;
    c = (q == 0) ? cr : (q == 1) ? -sr : (q == 2) ? -cr : sr;
}
__device__ __forceinline__ void p0_prologue(Frame& F, KP P) {
    const int tid = otid(), lane = tid & 63, wave = F.wave;
    {
        LAS float* cs = (LAS float*)(F.lds);
        LAS float* red = (LAS float*)(F.lds + 16384);
        for (int i = tid; i < 4096; i += 512) { const float v = P->c[i]; cs[i] = v / (1.f + __expf(-v)); }
        __syncthreads();
        float* mod = (float*)(F.ws + WS_MOD);
        for (int it = F.vcu; it < DEPTH * 96; it += F.G) {
            const int l = it / 96, n = (it % 96) * 64 + lane;
            const float* w = P->w_ada + ((size_t)l * 1024 + wave * 128) * 6144 + n;
            float a0 = 0.f, a1 = 0.f, a2 = 0.f, a3 = 0.f;
#pragma unroll 16
            for (int k = 0; k < 128; ++k) { const float wv = __builtin_nontemporal_load(w + (size_t)k * 6144); const int kk = wave * 128 + k; a0 += cs[kk] * wv; a1 += cs[1024 + kk] * wv; a2 += cs[2048 + kk] * wv; a3 += cs[3072 + kk] * wv; }
            red[(wave * 4 + 0) * 64 + lane] = a0; red[(wave * 4 + 1) * 64 + lane] = a1; red[(wave * 4 + 2) * 64 + lane] = a2; red[(wave * 4 + 3) * 64 + lane] = a3;
            __syncthreads();
            if (tid < 256) { const int b = tid >> 6, ln = tid & 63; float s = 0.f;
#pragma unroll
                for (int w8 = 0; w8 < 8; ++w8) s += red[(w8 * 4 + b) * 64 + ln];
                const int nn = (it % 96) * 64 + ln; mod[((size_t)l * 4 + b) * 6144 + nn] = s + P->b_ada[(size_t)l * 6144 + nn]; }
            __syncthreads();
        }
    }
    const int gt = F.vcu * 512 + tid, NGT = F.G * 512;
    {
        float* rope = (float*)(F.ws + WS_ROPE);
        for (int idx = gt; idx < NTOK * 8; idx += NGT) { const int tok = idx >> 3, i = idx & 7;
            const float inv = (i == 0) ? 1.0f : (i == 1) ? 0.1939227432012558f : (i == 2) ? 0.03760603070259094f : (i == 3) ? 0.007292664609849453f : (i == 4) ? 0.0014142135623842478f
                            : (i == 5) ? 0.00027424818836152554f : (i == 6) ? 5.318296098266728e-05f : 1.0313386155758053e-05f;
            const float ang = (float)P->pos[tok] * inv; double s, c; sincos_d((double)ang, s, c);
            rope[tok * 16 + i] = (float)c; rope[tok * 16 + 8 + i] = (float)s; }
    }
    {
        float* winf = (float*)(F.ws + WS_WINF); float* wrt = (float*)(F.ws + WS_WRT);
        for (int idx = gt; idx < DEPTH * 8 * 1024; idx += NGT) { const int k = idx & 1023, j = (idx >> 10) & 7, l = idx >> 13; winf[idx] = P->w_in[((size_t)l * 1024 + k) * INC + NQKV + j]; }
        for (int idx = gt; idx < DEPTH * 36 * 1024; idx += NGT) { const int k = idx & 1023, j = (idx >> 10) % 36, l = (idx >> 10) / 36;
            wrt[idx] = (j < 4) ? P->wrg[((size_t)l * 1024 + k) * 4 + j] : P->wre[((size_t)l * 1024 + k) * 32 + (j - 4)]; }
    }
    __syncthreads();
    {
        LAS float* scr = (LAS float*)(F.lds + wave * 16384);
        const int gw = F.vcu * 8 + wave, NGW = F.G * 8;
        const int nconv = (F.G >= 128) ? CONV_NDENSE : DEPTH * CONV_NIT;
        for (int it = gw; it < nconv; it += NGW) {
            const ConvItem c = conv_decode(P, F.ws, it / CONV_NIT, it % CONV_NIT);
            p0_transpose_item(c.W, c.ldw, c.K, c.WT, c.k0, c.n0, c.drow0, scr, lane);
        }
    }
}

__device__ __forceinline__ float log_sigmoid(float x) { return fminf(x, 0.f) - log1pf(__expf(-fabsf(x))); }

__device__ __forceinline__ void phase_norm1(Frame& F, KP P, const int l) {
    const int tid_ = otid();
    const int lane = tid_ & 63; const bool first = (l == 0), fin = (l == DEPTH);
    const float* mod = (const float*)(F.ws + WS_MOD);
    const bf16_t* ys = (const bf16_t*)(F.ws + WS_YS); bf16_t* xb = (bf16_t*)(F.ws + WS_X);
    bf16_t* hb = (bf16_t*)(F.ws + WS_H); float* lf = (float*)(F.ws + WS_LF);
    const float* winf = (const float*)(F.ws + WS_WINF) + (size_t)(fin ? 0 : l) * 8 * 1024;
    int gw = F.vcu * 8 + F.wave; asm volatile("" : "+s"(gw)); const int NGW = F.G * 8;
    if (!fin) {
#pragma unroll
        for (int i = 0; i < 4; ++i) { const int p = F.wave * 4 + i; __builtin_amdgcn_global_load_lds((const unsigned*)(winf + p * 256 + lane * 4), (LAS unsigned*)(F.lds + p * 1024), 16, 0, 0); }
    }
    bool staged = fin;
    for (int rb = gw; rb < NTOK / 8; rb += NGW) {
        const int row0 = rb * 8, b = row0 >> 12;
        f32x4 g[4], sc[4], sh[4], gp[4];
        const float* gsrc = fin ? P->g_final : P->g_mix + (size_t)l * 1024;
#pragma unroll
        for (int j = 0; j < 4; ++j) { g[j] = *(const f32x4*)(gsrc + 4 * lane + 256 * j); gp[j] = (f32x4){0.f, 0.f, 0.f, 0.f}; sc[j] = gp[j]; sh[j] = gp[j]; }
        if (!fin) {
            const float* m = mod + ((size_t)l * 4 + b) * 6144;
#pragma unroll
            for (int j = 0; j < 4; ++j) { sh[j] = *(const GAS f32x4*)(m + 4 * lane + 256 * j); sc[j] = *(const GAS f32x4*)(m + 1024 + 4 * lane + 256 * j); }
        }
        if (!first) { const float* m = mod + ((size_t)(l - 1) * 4 + b) * 6144 + 5 * 1024;
#pragma unroll
            for (int j = 0; j < 4; ++j) gp[j] = *(const GAS f32x4*)(m + 4 * lane + 256 * j); }
        f32x4 vn[4]; u32x2 xn[4], yan[4], ybn[4];
#define A_LOAD(row_) do { if (first) { _Pragma("unroll") for (int j = 0; j < 4; ++j) vn[j] = *(const f32x4*)(P->x + (size_t)(row_) * 1024 + 4 * lane + 256 * j); } \
            else { _Pragma("unroll") for (int j = 0; j < 4; ++j) { xn[j] = *(const GAS u32x2*)(xb + (size_t)(row_) * 1024 + 4 * lane + 256 * j); \
                yan[j] = *(const GAS u32x2*)(ys + (size_t)(2 * (row_)) * 1024 + 4 * lane + 256 * j); ybn[j] = *(const GAS u32x2*)(ys + (size_t)(2 * (row_) + 1) * 1024 + 4 * lane + 256 * j); } } } while (0)
        A_LOAD(row0);
        if (!staged) { asm volatile("s_waitcnt vmcnt(0)" ::: "memory"); __syncthreads(); staged = true; }
        for (int rr = 0; rr < 8; ++rr) {
            const int row = row0 + rr;
            f32x4 v[4]; u32x2 xa[4], ya[4], yb[4];
#pragma unroll
            for (int j = 0; j < 4; ++j) { v[j] = vn[j]; xa[j] = xn[j]; ya[j] = yan[j]; yb[j] = ybn[j]; }
            if (rr + 1 < 8) A_LOAD(row + 1);
            if (!first) {
#pragma unroll
                for (int j = 0; j < 4; ++j) { const u32x2 a = ya[j], bb = yb[j]; v[j] = (f32x4){bflo(xa[j].x), bfhi(xa[j].x), bflo(xa[j].y), bfhi(xa[j].y)};
                    v[j].x += gp[j].x * (bflo(a.x) + bflo(bb.x)); v[j].y += gp[j].y * (bfhi(a.x) + bfhi(bb.x)); v[j].z += gp[j].z * (bflo(a.y) + bflo(bb.y)); v[j].w += gp[j].w * (bfhi(a.y) + bfhi(bb.y)); }
            }
            float ss = 0.f;
#pragma unroll
            for (int j = 0; j < 4; ++j) ss += (v[j].x * v[j].x + v[j].y * v[j].y) + (v[j].z * v[j].z + v[j].w * v[j].w);
            const float rstd = __builtin_amdgcn_rsqf(wave_sum(ss) * (1.f / 1024.f) + EPS);
            if (fin) {
#pragma unroll
                for (int j = 0; j < 4; ++j) __builtin_nontemporal_store(v[j] * rstd * g[j], (GAS f32x4*)(P->out + (size_t)row * 1024 + 4 * lane + 256 * j));
                continue;
            }
#pragma unroll
            for (int j = 0; j < 4; ++j) { u32x2 o; o.x = cvtpk(v[j].x, v[j].y); o.y = cvtpk(v[j].z, v[j].w); *(GAS u32x2*)(xb + (size_t)row * 1024 + 4 * lane + 256 * j) = o; }
            f32x4 h[4];
#pragma unroll
            for (int j = 0; j < 4; ++j) { h[j] = (v[j] * rstd * g[j]) * (sc[j] + 1.0f) + sh[j];
                u32x2 o; o.x = cvtpk(h[j].x, h[j].y); o.y = cvtpk(h[j].z, h[j].w); *(GAS u32x2*)(hb + (size_t)row * 1024 + 4 * lane + 256 * j) = o; }
            float ff[8];
#pragma unroll
            for (int q = 0; q < 8; ++q) { f32x4 a4 = h[0] * *(const LAS f32x4*)(F.lds + (q * 1024 + 4 * lane) * 4);
#pragma unroll
                for (int j = 1; j < 4; ++j) a4 = a4 + h[j] * *(const LAS f32x4*)(F.lds + (q * 1024 + 4 * lane + 256 * j) * 4);
                ff[q] = wave_sum((a4.x + a4.y) + (a4.z + a4.w)); if ((q & 3) == 3) asm volatile("" ::: "memory"); }
            float mine = 0.f;
#pragma unroll
            for (int q = 0; q < 8; ++q) mine = (lane == q) ? ff[q] : mine;
            if (lane < 8) lf[(size_t)row * 8 + lane] = log_sigmoid(mine + P->b_forget[l * 8 + lane]);
        }
    }
    if (!staged) { asm volatile("s_waitcnt vmcnt(0)" ::: "memory"); __syncthreads(); }
}

__device__ __forceinline__ void phase_router(Frame& F, KP P, const int l) {
    const int tid_ = otid();
    const int lane = tid_ & 63, tid = tid_;
    const float* mod = (const float*)(F.ws + WS_MOD);
    bf16_t* hb = (bf16_t*)(F.ws + WS_H); const bf16_t* xb = (const bf16_t*)(F.ws + WS_X);
    const float* wrt = (const float*)(F.ws + WS_WRT) + (size_t)l * 36 * 1024;
    int* list = (int*)(F.ws + WS_LIST); float* wlist = (float*)(F.ws + WS_WLIST);
    unsigned* gcnt = (unsigned*)F.ctl + CW_CNT + l * 32 * 64;
    volatile LAS unsigned* lcnt = F.MISC + 32;
    volatile LAS unsigned* lbase = F.MISC + 64;
    {
#pragma unroll
        for (int i = 0; i < 16; ++i) { const int p = F.wave * 16 + i; __builtin_amdgcn_global_load_lds((const unsigned*)(wrt + 4 * 1024 + p * 256 + lane * 4), (LAS unsigned*)(F.lds + p * 1024), 16, 0, 0); }
    }
    for (int blk = F.vcu; blk < NTOK / 64; blk += F.G) {
        if (tid < 32) lcnt[tid] = 0u;
        const int row0 = blk * 64 + F.wave * 8, b = row0 >> 12;
        f32x4 g[4], sc[4], sh[4];
        const float* m = mod + ((size_t)l * 4 + b) * 6144;
#pragma unroll
        for (int j = 0; j < 4; ++j) { g[j] = *(const f32x4*)(P->g_ffn + (size_t)l * 1024 + 4 * lane + 256 * j); sh[j] = *(const GAS f32x4*)(m + 3 * 1024 + 4 * lane + 256 * j); sc[j] = *(const GAS f32x4*)(m + 4 * 1024 + 4 * lane + 256 * j); }
        int myE = 0, myEnt = 0; float myW = 0.f;
        f32x4 wg[4][4];
#pragma unroll
        for (int q = 0; q < 4; ++q)
#pragma unroll
            for (int j = 0; j < 4; ++j) wg[q][j] = *(const GAS f32x4*)(wrt + q * 1024 + 4 * lane + 256 * j);
        u32x2 vn[4];
#pragma unroll
        for (int j = 0; j < 4; ++j) vn[j] = *(const GAS u32x2*)(xb + (size_t)row0 * 1024 + 4 * lane + 256 * j);
        asm volatile("s_waitcnt vmcnt(0)" ::: "memory"); __syncthreads();
        for (int rr = 0; rr < 8; ++rr) {
            const int row = row0 + rr;
            f32x4 v[4];
#pragma unroll
            for (int j = 0; j < 4; ++j) v[j] = (f32x4){bflo(vn[j].x), bfhi(vn[j].x), bflo(vn[j].y), bfhi(vn[j].y)};
            if (rr + 1 < 8) {
#pragma unroll
                for (int j = 0; j < 4; ++j) vn[j] = *(const GAS u32x2*)(xb + (size_t)(row + 1) * 1024 + 4 * lane + 256 * j);
            }
            float ss = 0.f;
#pragma unroll
            for (int j = 0; j < 4; ++j) ss += (v[j].x * v[j].x + v[j].y * v[j].y) + (v[j].z * v[j].z + v[j].w * v[j].w);
            const float rstd = __builtin_amdgcn_rsqf(wave_sum(ss) * (1.f / 1024.f) + EPS);
            f32x4 h[4];
#pragma unroll
            for (int j = 0; j < 4; ++j) { h[j] = (v[j] * rstd * g[j]) * (sc[j] + 1.0f) + sh[j];
                u32x2 o; o.x = cvtpk(h[j].x, h[j].y); o.y = cvtpk(h[j].z, h[j].w); *(GAS u32x2*)(hb + (size_t)row * 1024 + 4 * lane + 256 * j) = o; }
            float gl[4];
#pragma unroll
            for (int q = 0; q < 4; ++q) { f32x4 a4 = h[0] * wg[q][0];
#pragma unroll
                for (int j = 1; j < 4; ++j) a4 = a4 + h[j] * wg[q][j];
                gl[q] = wave_sum((a4.x + a4.y) + (a4.z + a4.w)) + P->brg[l * 4 + q]; }
            int gs = 0; float gm = gl[0];
#pragma unroll
            for (int q = 1; q < 4; ++q) if (gl[q] > gm) { gm = gl[q]; gs = q; }
            float den = 0.f;
#pragma unroll
            for (int q = 0; q < 4; ++q) den += __expf(gl[q] - gm);
            const float pg = 1.0f / den;
            gs = __builtin_amdgcn_readfirstlane(gs);
            float el[8];
            const LAS unsigned char* wsel = F.lds + (size_t)(gs * 8) * 4096;
#pragma unroll
            for (int i = 0; i < 8; ++i) { f32x4 a4 = h[0] * *(const LAS f32x4*)(wsel + (i * 1024 + 4 * lane) * 4);
#pragma unroll
                for (int j = 1; j < 4; ++j) a4 = a4 + h[j] * *(const LAS f32x4*)(wsel + (i * 1024 + 4 * lane + 256 * j) * 4);
                el[i] = (a4.x + a4.y) + (a4.z + a4.w);
                if (i & 1) asm volatile("" ::: "memory"); }
#pragma unroll
            for (int i = 0; i < 8; ++i) el[i] = wave_sum(el[i]) + P->bre[l * 32 + gs * 8 + i];
            int i1 = 0; float l1 = el[0];
#pragma unroll
            for (int i = 1; i < 8; ++i) if (el[i] > l1) { l1 = el[i]; i1 = i; }
            int i2 = -1; float l2 = -3.0e38f;
#pragma unroll
            for (int i = 0; i < 8; ++i) if (i != i1 && el[i] > l2) { l2 = el[i]; i2 = i; }
            const float e21 = __expf(l2 - l1), w1 = pg / (1.0f + e21), w2 = pg * e21 / (1.0f + e21);
            if (lane == 2 * rr) { myE = gs * 8 + i1; myW = w1; myEnt = row * 2; }
            if (lane == 2 * rr + 1) { myE = gs * 8 + i2; myW = w2; myEnt = row * 2 + 1; }
        }
        unsigned lpos = 0u;
        if (lane < 16) lpos = __hip_atomic_fetch_add((LAS unsigned*)&lcnt[myE], 1u, __ATOMIC_RELAXED, __HIP_MEMORY_SCOPE_WORKGROUP);
        __syncthreads();
        if (tid < 32) { const unsigned n = lcnt[tid]; lbase[tid] = n ? __hip_atomic_fetch_add(gcnt + tid * 64, n, __ATOMIC_RELAXED, __HIP_MEMORY_SCOPE_AGENT) : 0u; }
        __syncthreads();
        if (lane < 16) { const unsigned p = lbase[myE] + lpos; list[(size_t)myE * NTOK + p] = myEnt; wlist[(size_t)myE * NTOK + p] = myW; }
        __syncthreads();
    }
}

__device__ __forceinline__ void scan_item(Frame& F, int bh) {
    const int tid_ = otid();
    const int tid = tid_, lane = tid & 63, wave = F.wave, b = bh >> 3, hh = bh & 7;
    const float* lf = (const float*)(F.ws + WS_LF); float* cf = (float*)(F.ws + WS_CF) + (size_t)bh * SEQ;
    LAS float* sw = (LAS float*)(F.lds + TAB_OFF);
    float v[8]; float s = 0.f;
#pragma unroll
    for (int i = 0; i < 8; ++i) { v[i] = *(const GAS float*)(lf + ((size_t)b * SEQ + tid * 8 + i) * 8 + hh); s += v[i]; v[i] = s; }
    float inc = s;
#define SCAN_DPP(ctrl, rm) inc += __builtin_bit_cast(float, __builtin_amdgcn_update_dpp(0, __builtin_bit_cast(int, inc), ctrl, rm, 0xF, false))
    SCAN_DPP(0x111, 0xF); SCAN_DPP(0x112, 0xF); SCAN_DPP(0x114, 0xF); SCAN_DPP(0x118, 0xF); SCAN_DPP(0x142, 0xA); SCAN_DPP(0x143, 0xC);
#undef SCAN_DPP
    if (lane == 63) sw[wave] = inc;
    __syncthreads();
    float base = inc - s;
    for (int w = 0; w < wave; ++w) base += sw[w];
#pragma unroll
    for (int i = 0; i < 8; ++i) cf[tid * 8 + i] = -(base + v[i]) * LOG2E;
    __syncthreads();
}

using pg8::Unit;
struct EpiQKV {
    bf16_t* O; const float* rope;
    __device__ __forceinline__ void operator()(const f32x4 (&acc)[2][2][4][2], const Unit& u, int wr, int wc, int fr, int fq) const {
        const int colt = u.pn * 256, region = colt >> 9;
        const float sc = (region == 0 || region == 3) ? C2 : 1.0f;
        const bool do_rope = region < 2, rot = ((wc & 1) == 0) && (fq < 2);
        const float sgn = (fq == 0) ? -1.0f : 1.0f;
        const int col0 = colt + wc * 32 + 8 * fq;
        f32x4 ncs0 = {1.f, 1.f, 1.f, 1.f}, ncs1 = ncs0, nsn0 = {0.f, 0.f, 0.f, 0.f}, nsn1 = nsn0;
        if (do_rope) { const GAS f32x4* rp = (const GAS f32x4*)(rope + (size_t)(u.pm * 256 + wr * 64 + fr) * 16); ncs0 = rp[0]; ncs1 = rp[1]; nsn0 = rp[2]; nsn1 = rp[3]; }
#pragma unroll
        for (int gi = 0; gi < 8; ++gi) {
                const int ai = gi >> 2, m = gi & 3;
                const int row = u.pm * 256 + ai * 128 + wr * 64 + m * 16 + fr;
                const f32x4 cs0 = ncs0, cs1 = ncs1, sn0 = nsn0, sn1 = nsn1;
                if (do_rope && gi + 1 < 8) { const int nrow = u.pm * 256 + ((gi + 1) >> 2) * 128 + wr * 64 + ((gi + 1) & 3) * 16 + fr; const GAS f32x4* rp = (const GAS f32x4*)(rope + (size_t)nrow * 16); ncs0 = rp[0]; ncs1 = rp[1]; nsn0 = rp[2]; nsn1 = rp[3]; }
                bf16_t* rowp = O + (size_t)row * NQKV + col0;
#pragma unroll
                for (int bj = 0; bj < 2; ++bj) {
                    f32x4 v0 = acc[ai][bj][m][0], v1 = acc[ai][bj][m][1];
                    if (do_rope) {
                        f32x4 p0, p1;
#pragma unroll
                        for (int k = 0; k < 4; ++k) { p0[k] = xor16_f(v0[k]); p1[k] = xor16_f(v1[k]); }
                        if (rot) { v0 = v0 * cs0 + p0 * sn0 * sgn; v1 = v1 * cs1 + p1 * sn1 * sgn; }
                    }
                    v0 = v0 * sc; v1 = v1 * sc;
                    u32x4 w; w.x = cvtpk(v0[0], v0[1]); w.y = cvtpk(v0[2], v0[3]); w.z = cvtpk(v1[0], v1[1]); w.w = cvtpk(v1[2], v1[3]);
                    *(GAS u32x4*)(rowp + bj * 128) = w; }
                asm volatile("" ::: "memory");
        }
    }
};
struct EpiRes {
    bf16_t* X; const float* gt;
    __device__ __forceinline__ void operator()(const f32x4 (&acc)[2][2][4][2], const Unit& u, int wr, int wc, int fr, int fq) const {
        const int col0 = u.pn * 256 + wc * 32 + 8 * fq; const int b = (u.pm * 256) >> 12;
        f32x4 gv[2][2];
#pragma unroll
        for (int bj = 0; bj < 2; ++bj)
#pragma unroll
            for (int n = 0; n < 2; ++n) gv[bj][n] = *(const GAS f32x4*)(gt + (size_t)b * 6144 + col0 + bj * 128 + 4 * n);
#pragma unroll
        for (int ai = 0; ai < 2; ++ai)
#pragma unroll
            for (int m = 0; m < 4; ++m) { bf16_t* rowp = X + (size_t)(u.pm * 256 + ai * 128 + wr * 64 + m * 16 + fr) * 1024 + col0;
#pragma unroll
                for (int bj = 0; bj < 2; ++bj) { GAS u32x4* p = (GAS u32x4*)(rowp + bj * 128); const u32x4 w = *p;
                    const f32x4 v0 = (f32x4){bflo(w.x), bfhi(w.x), bflo(w.y), bfhi(w.y)} + gv[bj][0] * acc[ai][bj][m][0], v1 = (f32x4){bflo(w.z), bfhi(w.z), bflo(w.w), bfhi(w.w)} + gv[bj][1] * acc[ai][bj][m][1];
                    u32x4 o; o.x = cvtpk(v0[0], v0[1]); o.y = cvtpk(v0[2], v0[3]); o.z = cvtpk(v1[0], v1[1]); o.w = cvtpk(v1[2], v1[3]); *p = o; }
                if (m == 3) asm volatile("" ::: "memory"); }
    }
};
struct EpiGU {
    bf16_t* act;
    __device__ __forceinline__ void operator()(const f32x4 (&acc)[2][2][4][2], const Unit& u, int wr, int wc, int fr, int fq) const {
        const int col0 = u.pn * 128 + wc * 32 + 8 * fq;
#pragma unroll
        for (int ai = 0; ai < 2; ++ai)
#pragma unroll
            for (int m = 0; m < 4; ++m) { const int row = u.pm * 256 + ai * 128 + wr * 64 + m * 16 + fr;
                float o[8];
#pragma unroll
                for (int n = 0; n < 2; ++n)
#pragma unroll
                    for (int k = 0; k < 4; ++k) { const float gte = acc[ai][0][m][n][k], up = acc[ai][1][m][n][k]; o[4 * n + k] = gte * __builtin_amdgcn_rcpf(1.0f + __expf(-gte)) * up;        }
                u32x4 w; w.x = cvtpk(o[0], o[1]); w.y = cvtpk(o[2], o[3]); w.z = cvtpk(o[4], o[5]); w.w = cvtpk(o[6], o[7]);
                *(GAS u32x4*)(act + (size_t)row * DEXP + col0) = w; }
    }
};
struct EpiDown {
    bf16_t* ys; const LAS int* tidx; const LAS float* tw;
    __device__ __forceinline__ void operator()(const f32x4 (&acc)[2][2][4][2], const Unit& u, int wr, int wc, int fr, int fq) const {
        const int col0 = u.pn * 256 + wc * 32 + 8 * fq;
#pragma unroll
        for (int ai = 0; ai < 2; ++ai)
#pragma unroll
            for (int m = 0; m < 4; ++m) { const int r = ai * 128 + wr * 64 + m * 16 + fr; const int dst = tidx[u.slot * 256 + r]; const float w = tw[u.slot * 256 + r];
                if (dst >= 0) { bf16_t* rowp = ys + (size_t)dst * 1024 + col0;
#pragma unroll
                    for (int bj = 0; bj < 2; ++bj) { const f32x4 v0 = acc[ai][bj][m][0] * w, v1 = acc[ai][bj][m][1] * w;
                        u32x4 o; o.x = cvtpk(v0[0], v0[1]); o.y = cvtpk(v0[2], v0[3]); o.z = cvtpk(v1[0], v1[1]); o.w = cvtpk(v1[2], v1[3]);
                        *(GAS u32x4*)(rowp + bj * 128) = o; } }
                asm volatile("" ::: "memory"); }
    }
};

constexpr int MAXU = 8, MAXRB = 160;
template <bool GATHER_> struct MoeSched {
    static constexpr bool GATHER = GATHER_;
    const LAS int* rbt;
    const LAS unsigned* toff;
    int G, c, NB, K; const char* A; const char* Bt; size_t bstride;
    __device__ __forceinline__ bool next(int i, Unit& u) const { const int L = i * G + c; if (L >= NB * 4 || i >= MAXU) return false; u.pm = L >> 2; u.pn = L & 3; u.e = rbt[u.pm]; u.slot = i; return true; }
    __device__ __forceinline__ const char* aptr(const Unit& u) const { return A + (size_t)u.pm * 256 * K * 2; }
    __device__ __forceinline__ const char* bptr(const Unit& u) const { return Bt + (size_t)u.e * bstride + (size_t)u.pn * 256 * K * 2; }
};
template <bool GATHER_, bool REUSE> __device__ __forceinline__ void moe_tables(Frame& F, int l, MoeSched<GATHER_>& S) {
    LAS int* rbt = (LAS int*)(F.lds + RBT_OFF); LAS int* T0 = (LAS int*)(F.lds + TAB_OFF); LAS float* T1 = (LAS float*)(F.lds + TAB_OFF + MAXU * 1024); LAS int* T2 = (LAS int*)(F.lds + TENT_OFF);
    const unsigned* gcnt = (const unsigned*)F.ctl + CW_CNT + l * 32 * 64;
    const int* list = (const int*)(F.ws + WS_LIST); const float* wlist = (const float*)(F.ws + WS_WLIST);
    const int tid = otid();
    if (REUSE) { S.rbt = rbt; S.toff = (const LAS unsigned*)T0; S.G = F.G; S.c = F.vcu; S.NB = rbt[480]; return; }
    if (F.wave == 0) {
        const int e = tid & 31;
        const int myc = (tid < 32) ? (int)ld_agent(gcnt + e * 64) : 0;
        const int nblk = (myc + 255) >> 8;
        int base = 0, run = 0;
        for (int k = 0; k < NEXP; ++k) { const int nk = __builtin_amdgcn_readlane(nblk, k); base = (e == k) ? run : base; run += nk; }
        if (tid < 32) for (int j = 0; j < nblk; ++j) { const int nb = base + j; if (nb < MAXRB) { rbt[nb] = e; rbt[160 + nb] = 256 * j; rbt[320 + nb] = (myc - 256 * j) < 256 ? (myc - 256 * j) : 256; } }
        if (tid == 0) rbt[480] = run < MAXRB ? run : MAXRB; }
    __syncthreads();
    const int NB = rbt[480];
    {
        const int half = tid >> 8, r = tid & 255;
        for (int i0 = 0; i0 < MAXU; i0 += 4) {
            if (i0 * F.G + F.vcu >= NB * 4) break;
            int ent2[2]; float w2[2]; bool uv2[2];
#pragma unroll
            for (int p = 0; p < 2; ++p) { const int i = i0 + 2 * p + half, L = i * F.G + F.vcu; const bool uv = L < NB * 4; const int rb = uv ? (L >> 2) : 0;
                const int e = rbt[rb], s0 = rbt[160 + rb], nv = uv ? rbt[320 + rb] : 0; const bool ok = r < nv;
                const size_t li = (size_t)e * NTOK + s0 + (ok ? r : 0);
                const int ev = *(const GAS int*)(list + li); const float wv = *(const GAS float*)(wlist + li);
                uv2[p] = uv; ent2[p] = ok ? ev : -1; w2[p] = ok ? wv : 0.f; }
#pragma unroll
            for (int p = 0; p < 2; ++p) { const int i = i0 + 2 * p + half;
                if (uv2[p]) { T0[i * 256 + r] = (ent2[p] < 0 ? 0 : (ent2[p] >> 1)) * (DM * 2); T1[i * 256 + r] = w2[p]; T2[i * 256 + r] = ent2[p]; } }
        }
    }
    __syncthreads();
    S.rbt = rbt; S.toff = (const LAS unsigned*)T0; S.G = F.G; S.c = F.vcu; S.NB = NB;
}

namespace att {
constexpr float NEG = -1.0e30f;
constexpr float THR = 8.0f;
__device__ __forceinline__ int crow(int r, int hi) { return (r & 3) + 8 * (r >> 2) + 4 * hi; }
__device__ __forceinline__ s16x4 vtr(const LAS char* p) { typedef short v4i16_t __attribute__((ext_vector_type(4))); return __builtin_bit_cast(s16x4, __builtin_amdgcn_ds_read_tr16_b64_v4i16((LAS v4i16_t*)p)); }
__device__ __forceinline__ bf16x8 pack8(const f32x16& p, int s) { u32x4 w; w.x = cvtpk(p[8 * s + 0], p[8 * s + 1]); w.y = cvtpk(p[8 * s + 2], p[8 * s + 3]); w.z = cvtpk(p[8 * s + 4], p[8 * s + 5]); w.w = cvtpk(p[8 * s + 6], p[8 * s + 7]); return __builtin_bit_cast(bf16x8, w); }
__device__ __forceinline__ void dma16(const void* g, LAS unsigned char* l) { __builtin_amdgcn_global_load_lds((const unsigned*)g, (LAS unsigned*)l, 16, 0, 0); }
__device__ __forceinline__ void dma4(const void* g, LAS unsigned char* l) { __builtin_amdgcn_global_load_lds((const unsigned*)g, (LAS unsigned*)l, 4, 0, 0); }
#define ATT_WAIT_BAR() asm volatile("s_waitcnt vmcnt(0) lgkmcnt(0)\n\ts_barrier" ::: "memory")

#define ATT_SB() __builtin_amdgcn_sched_barrier(0)
template <int NSUB, int NDB, bool BIAS, bool MASK>
__device__ __forceinline__ void tileN(const LAS char* K0, const LAS char* V0, const LAS float* B0, const LAS char* K1, const LAS char* V1, const LAS float* B1,
                                      const bf16x8 (&qf)[4], f32x16 (&o)[NDB], float& m, float& l, f32x16& negv, int lane, int dq) {
    static_assert(!MASK || NSUB == 1, "mask only on single tiles");
    const int r32 = lane & 31, hi = lane >> 5;
    constexpr int NQ = NSUB * 4, DQ = (NDB == 4) ? 1 : 3, NP = NSUB * NDB * 4, DP = (NDB == 4) ? 2 : 4;
    f32x16 p[2 * NSUB];
    bf16x8 kb[DQ + 1][2], vbuf[DP + 1];
    const int klane = (r32 >> 4) * 1024 + hi * 256 + (r32 & 15) * 16;
    const LAS char* kl0 = K0 + klane; const LAS char* kl1 = K1 + klane;
    const size_t voff = (size_t)(4 * hi + ((lane & 15) >> 2)) * 64 + ((lane >> 4) & 1) * 32 + (lane & 3) * 8;
    const LAS char* vl0 = V0 + voff; const LAS char* vl1 = V1 + voff;
#define ATT_KLOAD(i_) do { const LAS char* kl_ = (((i_) / 4) ? kl1 : kl0) + (((i_) % 4) >> 1) * 4096 + ((i_) & 1) * 512; kb[(i_) % (DQ + 1)][0] = *(const LAS bf16x8*)(kl_); kb[(i_) % (DQ + 1)][1] = *(const LAS bf16x8*)(kl_ + 2048); } while (0)
#define ATT_VLOAD(j_) do { const LAS char* vl_ = (((j_) / (NDB * 4)) ? vl1 : vl0) + ((j_) % NDB) * 4096 + (((j_) / NDB) % 4) * 1024; const s16x4 lo_ = vtr(vl_), hh_ = vtr(vl_ + 512); \
        vbuf[(j_) % (DP + 1)] = (bf16x8){lo_[0], lo_[1], lo_[2], lo_[3], hh_[0], hh_[1], hh_[2], hh_[3]}; } while (0)
    if (BIAS) {
#pragma unroll
        for (int s = 0; s < NSUB; ++s) { const LAS float* Bs = s ? B1 : B0;
#pragma unroll
            for (int g = 0; g < 4; ++g) { const f32x4 b0 = *(const LAS f32x4*)(Bs + 8 * g + 4 * hi), b1 = *(const LAS f32x4*)(Bs + 32 + 8 * g + 4 * hi);
#pragma unroll
                for (int k = 0; k < 4; ++k) { p[2 * s][4 * g + k] = b0[k]; p[2 * s + 1][4 * g + k] = b1[k]; } } }
    }
#pragma unroll
    for (int i = 0; i < DQ; ++i) ATT_KLOAD(i);
    ATT_SB();
    if (BIAS) {
#pragma unroll
        for (int t = 0; t < 2 * NSUB; ++t)
#pragma unroll
            for (int r = 0; r < 16; ++r) p[t][r] -= m;
    } else {
#pragma unroll
        for (int t = 0; t < 2 * NSUB; ++t)
#pragma unroll
            for (int r = 0; r < 16; ++r) p[t][r] = -m;
    }
#pragma unroll
    for (int i = DQ; i < NQ + DQ; ++i) {
        if (i < NQ) ATT_KLOAD(i);
        { const int j = i - DQ, s = j / 4, ks = j % 4;
          p[2 * s] = __builtin_amdgcn_mfma_f32_32x32x16_bf16(kb[j % (DQ + 1)][0], qf[ks], p[2 * s], 0, 0, 0);
          p[2 * s + 1] = __builtin_amdgcn_mfma_f32_32x32x16_bf16(kb[j % (DQ + 1)][1], qf[ks], p[2 * s + 1], 0, 0, 0); }
        ATT_SB();
    }
#pragma unroll
    for (int j = 0; j < DP; ++j) ATT_VLOAD(j);
    ATT_SB();
    if (MASK) {
        int dq4 = dq - 4 * hi; asm volatile("" : "+v"(dq4));
#pragma unroll
        for (int r = 0; r < 16; ++r) { const int c = (r & 3) + 8 * (r >> 2); if (c > dq4) p[0][r] = NEG; if (c + 32 > dq4) p[1][r] = NEG; }
    }
    float mx = fmaxf(p[0][0], p[1][0]);
#pragma unroll
    for (int t = 0; t < 2 * NSUB; ++t)
#pragma unroll
        for (int r = 0; r < 16; ++r) mx = fmaxf(mx, p[t][r]);
    mx = max32_f(mx);
    if (__any(mx > THR)) {
        const float d = (mx > THR) ? mx : 0.0f, alpha = __builtin_amdgcn_exp2f(-d);
        m += d; l *= alpha;
#pragma unroll
        for (int db = 0; db < NDB; ++db) o[db] = o[db] * alpha;
#pragma unroll
        for (int t = 0; t < 2 * NSUB; ++t)
#pragma unroll
            for (int r = 0; r < 16; ++r) p[t][r] -= d;
    }
    float s_ = 0.f;
#pragma unroll
    for (int t = 0; t < 2; ++t)
#pragma unroll
        for (int r = 0; r < 16; ++r) { p[t][r] = __builtin_amdgcn_exp2f(p[t][r]); s_ += p[t][r]; }
    bf16x8 pb[4];
    ATT_SB();
#pragma unroll
    for (int i = DP; i < NP + DP; ++i) {
        if (i < NP) ATT_VLOAD(i);
        { const int j = i - DP, s = j / (NDB * 4), kk = (j / NDB) % 4, db = j % NDB;
          if (j % (NDB * 4) == 0) { pb[0] = pack8(p[2 * s], 0); pb[1] = pack8(p[2 * s], 1); pb[2] = pack8(p[2 * s + 1], 0); pb[3] = pack8(p[2 * s + 1], 1); }
          o[db] = __builtin_amdgcn_mfma_f32_32x32x16_bf16(vbuf[j % (DP + 1)], pb[kk], o[db], 0, 0, 0);
          if (NSUB == 2 && j < NDB * 4) { constexpr int PER = 32 / (NDB * 4);
#pragma unroll
              for (int e = 0; e < PER; ++e) { const int idx = j * PER + e, t = 2 + idx / 16, r = idx % 16; p[t][r] = __builtin_amdgcn_exp2f(p[t][r]); s_ += p[t][r]; } } }
        ATT_SB();
    }
    l += s_;
#undef ATT_KLOAD
#undef ATT_VLOAD
}

__device__ __forceinline__ void fox_unit(Frame& F, KP P, int l, int b, int hf, int qb, const int cbase) {
    const int tid_ = otid();
    const int lane = tid_ & 63, wid = F.wave, r32 = lane & 31, hi = lane >> 5;
    const bf16_t* qkv = (const bf16_t*)(F.ws + WS_QKV); bf16_t* ao = (bf16_t*)(F.ws + WS_ATT);
    const float* ncf = (const float*)(F.ws + WS_CF) + (size_t)(b * 8 + hf) * SEQ;
    const size_t rowbase = (size_t)b * SEQ; const int t0 = qb * 256, NU = 2 * qb + 2, tw = t0 + 32 * wid;
    constexpr int SLOT = 16640;
    bf16x8 qf[4];
    { const bf16_t* Qw = qkv + (rowbase + tw + r32) * NQKV + 1536 + hf * 64;
#pragma unroll
      for (int ks = 0; ks < 4; ++ks) qf[ks] = *(const GAS bf16x8*)(Qw + 16 * ks + 8 * hi); }
    const char* kvbase = (const char*)(qkv + rowbase * NQKV + hf * 64);
    const unsigned koff = (unsigned)((16 * (wid & 3) + (lane & 15)) * NQKV + 2048 + (4 * (wid >> 2) + (lane >> 4)) * 8) * 2u;
    const unsigned vof2 = (unsigned)((16 * (wid & 3) + (lane >> 2)) * NQKV + 2560 + (wid >> 2) * 32 + (lane & 3) * 8) * 2u;
    const unsigned boff = (unsigned)lane * 4u;
    f32x16 o[2], negv; float m = 0.f, lsum = 0.f;
#pragma unroll
    for (int db = 0; db < 2; ++db)
#pragma unroll
        for (int r = 0; r < 16; ++r) { o[db][r] = 0.f; negv[r] = 0.f; }
#define FOX_ISSUE(u) do { _Pragma("unroll") for (int s_ = 0; s_ < 2; ++s_) { const int j_ = 2 * (u) + s_; LAS unsigned char* sl_ = F.lds + (j_ & 3) * SLOT; \
        const char* tb_ = kvbase + (size_t)j_ * 64 * NQKV * 2; dma16(tb_ + koff, sl_ + wid * 1024); dma16(tb_ + vof2, sl_ + 8192 + wid * 1024); if (wid == (j_ & 7)) dma4((const char*)(ncf + j_ * 64) + boff, sl_ + 16384); } } while (0)
    FOX_ISSUE(NU - 1);
    LAS unsigned char* cbuf = F.lds + 4 * SLOT + wid * 8448;
    const bool conv = F.G >= 128; const int nit = (l + 1 < DEPTH) ? CONV_NIT : CONV_NMOE;
    int rprev = -1;
    for (int u = 0; u < NU; ++u) {
        ATT_WAIT_BAR();
        if (u + 1 < NU) FOX_ISSUE(NU - 2 - u);
        if (conv) {
            if (rprev >= 0) { const ConvItem c = conv_decode_ph(P, F.ws, l, rprev); conv_consume(c, cbuf, lane); }
            const int nper = (CONV_NIT + F.G - 1) / F.G, t = ((cbase + u) * 8 + wid) * nper, r = (t / 272) * F.G + F.vcu; rprev = ((t % 272) < nper && r < nit) ? r : -1;
            if (rprev >= 0) { const ConvItem c = conv_decode_ph(P, F.ws, l, rprev); conv_issue(c, cbuf, lane); }
        }
        const int ja = 2 * (NU - 1 - u), jb = ja + 1;
        const LAS char* sa = (const LAS char*)F.lds + (ja & 3) * SLOT; const LAS char* sb = (const LAS char*)F.lds + (jb & 3) * SLOT;
        if (64 * jb + 63 <= tw) tileN<2, 2, true, false>(sa, sa + 8192, (const LAS float*)(sa + 16384), sb, sb + 8192, (const LAS float*)(sb + 16384), qf, o, m, lsum, negv, lane, 0);
        else {
            if (64 * jb <= tw + 31) tileN<1, 2, true, true>(sb, sb + 8192, (const LAS float*)(sb + 16384), sb, sb + 8192, (const LAS float*)(sb + 16384), qf, o, m, lsum, negv, lane, tw + r32 - 64 * jb);
            if (64 * ja + 63 <= tw) tileN<1, 2, true, false>(sa, sa + 8192, (const LAS float*)(sa + 16384), sa, sa + 8192, (const LAS float*)(sa + 16384), qf, o, m, lsum, negv, lane, 0);
            else if (64 * ja <= tw + 31) tileN<1, 2, true, true>(sa, sa + 8192, (const LAS float*)(sa + 16384), sa, sa + 8192, (const LAS float*)(sa + 16384), qf, o, m, lsum, negv, lane, tw + r32 - 64 * ja);
        }
    }
#undef FOX_ISSUE
    if (conv && rprev >= 0) { asm volatile("s_waitcnt vmcnt(0)" ::: "memory"); const ConvItem c = conv_decode_ph(P, F.ws, l, rprev); conv_consume(c, cbuf, lane); }
    const float lt = sum32_f(lsum), inv = 1.0f / lt;
    float ss = 0.f;
#pragma unroll
    for (int db = 0; db < 2; ++db)
#pragma unroll
        for (int r = 0; r < 16; ++r) { o[db][r] *= inv; ss += o[db][r] * o[db][r]; }
    ss = sum32_f(ss);
    const float rn = 1.0f / sqrtf(ss * (1.f / 64.f) + EPS);
    bf16_t* orow = ao + (rowbase + tw + r32) * 1024 + 512 + hf * 64;
#pragma unroll
    for (int db = 0; db < 2; ++db)
#pragma unroll
        for (int g = 0; g < 4; ++g) { const int d0 = db * 32 + 8 * g + 4 * hi; const f32x4 gg = *(const LAS f32x4*)(F.lds + RBT_OFF + d0 * 4);
            u32x2 w; w.x = cvtpk(o[db][4 * g] * rn * gg.x, o[db][4 * g + 1] * rn * gg.y); w.y = cvtpk(o[db][4 * g + 2] * rn * gg.z, o[db][4 * g + 3] * rn * gg.w);
            *(GAS u32x2*)(orow + d0) = w; }
    __syncthreads();
}

__device__ __forceinline__ void diff_unit(Frame& F, KP P, int l, int b, int hd, int qbp, float lam, float osc) {
    const int tid_ = otid();
    const int lane = tid_ & 63, wid = F.wave, r32 = lane & 31, hi = lane >> 5, map = wid >> 2, wq = wid & 3;
    const bf16_t* qkv = (const bf16_t*)(F.ws + WS_QKV); bf16_t* ao = (bf16_t*)(F.ws + WS_ATT);
    const size_t rowbase = (size_t)b * SEQ; const int t0 = qbp * 128, NU = qbp + 1, tw = t0 + 32 * wq, jmax = 2 * qbp + (wq >> 1);
    constexpr int SLOT = 32768;
    bf16x8 qf[4];
    { const bf16_t* Qw = qkv + (rowbase + tw + r32) * NQKV + hd * 128 + map * 64;
#pragma unroll
      for (int ks = 0; ks < 4; ++ks) qf[ks] = *(const GAS bf16x8*)(Qw + 16 * ks + 8 * hi); }
    const char* kvbase = (const char*)(qkv + rowbase * NQKV + hd * 128);
    const unsigned koff = (unsigned)((16 * (wid & 3) + (lane & 15)) * NQKV + 512 + (4 * (wid >> 2) + (lane >> 4)) * 8) * 2u;
    const unsigned vof2 = (unsigned)((16 * (wid & 3) + (lane >> 2)) * NQKV + 1024 + (wid >> 2) * 32 + (lane & 3) * 8) * 2u;
    const int vd = 16384 + (wid >> 2) * 4096 + (wid & 3) * 1024;
    f32x16 o[4], negv; float m = 0.f, lsum = 0.f;
#pragma unroll
    for (int db = 0; db < 4; ++db)
#pragma unroll
        for (int r = 0; r < 16; ++r) { o[db][r] = 0.f; negv[r] = 0.f; }
#define DIFF_ISSUE(u) do { _Pragma("unroll") for (int s_ = 0; s_ < 2; ++s_) { const int j_ = 2 * (u) + s_; LAS unsigned char* sl_ = F.lds + (j_ & 3) * SLOT; const size_t off_ = (size_t)j_ * 64 * NQKV; \
        const char* tb_ = kvbase + off_ * 2; dma16(tb_ + koff, sl_ + wid * 1024); dma16(tb_ + koff + 128, sl_ + 8192 + wid * 1024); dma16(tb_ + vof2, sl_ + vd); dma16(tb_ + vof2 + 128, sl_ + vd + 8192); } } while (0)
    DIFF_ISSUE(0);
    for (int u = 0; u < NU; ++u) {
        ATT_WAIT_BAR();
        if (u + 1 < NU) DIFF_ISSUE(u + 1);
        const int ja = 2 * u, jb = ja + 1;
        const LAS char* sa = (const LAS char*)F.lds + (ja & 3) * SLOT; const LAS char* sb = (const LAS char*)F.lds + (jb & 3) * SLOT;
        if (jb <= jmax) tileN<2, 4, false, false>(sa + map * 8192, sa + 16384, (const LAS float*)sa, sb + map * 8192, sb + 16384, (const LAS float*)sb, qf, o, m, lsum, negv, lane, 0);
        else if (ja <= jmax) tileN<1, 4, false, false>(sa + map * 8192, sa + 16384, (const LAS float*)sa, sa + map * 8192, sa + 16384, (const LAS float*)sa, qf, o, m, lsum, negv, lane, 0);
    }
#undef DIFF_ISSUE
    const float lt = sum32_f(lsum), inv = 1.0f / lt;
    __syncthreads();
    LAS float* X = (LAS float*)F.lds + wq * 4096;
    if (map == 1) {
#pragma unroll
        for (int db = 0; db < 4; ++db)
#pragma unroll
            for (int r = 0; r < 16; ++r) X[(db * 16 + r) * 64 + lane] = o[db][r] * inv;
    }
    __syncthreads();
    if (map == 0) {
        float ss = 0.f;
#pragma unroll
        for (int db = 0; db < 4; ++db)
#pragma unroll
            for (int r = 0; r < 16; ++r) { const float v = o[db][r] * inv - lam * X[(db * 16 + r) * 64 + lane]; o[db][r] = v; ss += v * v; }
        ss = sum32_f(ss);
        const float rn = osc / sqrtf(ss * (1.f / 128.f) + EPS);
        bf16_t* orow = ao + (rowbase + tw + r32) * 1024 + hd * 128;
#pragma unroll
        for (int db = 0; db < 4; ++db)
#pragma unroll
            for (int g = 0; g < 4; ++g) { const int d0 = db * 32 + 8 * g + 4 * hi; const f32x4 gg = *(const LAS f32x4*)(F.lds + RBT_OFF + 256 + d0 * 4);
                u32x2 w; w.x = cvtpk(o[db][4 * g] * rn * gg.x, o[db][4 * g + 1] * rn * gg.y); w.y = cvtpk(o[db][4 * g + 2] * rn * gg.z, o[db][4 * g + 3] * rn * gg.w);
                *(GAS u32x2*)(orow + d0) = w; }
    }
    __syncthreads();
}
}


__device__ __forceinline__ void phase_attn(Frame& F, KP P, const int l) {
    const int ln_ = otid() & 63;
    const float a1 = wave_sum(P->lq1[l * 64 + ln_] * P->lk1[l * 64 + ln_]), a2 = wave_sum(P->lq2[l * 64 + ln_] * P->lk2[l * 64 + ln_]);
    { const int t_ = otid(); LAS float* gl_ = (LAS float*)(F.lds + RBT_OFF); if (t_ < 64) gl_[t_] = P->g_fox[l * 64 + t_]; else if (t_ < 192) gl_[t_] = P->g_subln[l * 128 + t_ - 64]; __syncthreads(); }
    const float linit = (l == 0) ? 0.2f : (l == 1) ? 0.35550906759096934f : (l == 2) ? 0.47071301834358414f : 0.5560582041556406f;
    const float lam = __builtin_bit_cast(float, __builtin_amdgcn_readfirstlane(__builtin_bit_cast(int, expf(a1) - expf(a2) + linit))), osc = __builtin_bit_cast(float, __builtin_amdgcn_readfirstlane((l == 0) ? 0x3f4ccccd : (l == 1) ? 0x3f24fd5c : (l == 2) ? 0x3f077f5a : 0x3ee34c57));
    int cst = 0;
    for (int u = F.vcu; u < 256; u += F.G) {
        { const int bh = u >> 4, p = u & 15;
#pragma nounroll
          for (int k = 0; k < 2; ++k) att::diff_unit(F, P, l, bh >> 2, bh & 3, k ? 31 - p : p, lam, osc); }
        { const int bh = u >> 3, p = u & 7;
#pragma nounroll
          for (int k = 0; k < 2; ++k) att::fox_unit(F, P, l, bh >> 3, bh & 7, k ? 15 - p : p, k ? cst + 2 * p + 2 : cst);
          cst += 34; }
    }
}

__global__ void __launch_bounds__(512, 2) fwd_kernel(Params P_unused) {
    extern __shared__ __attribute__((aligned(16))) unsigned char lds[];
    Frame F;
    F.lds = (LAS unsigned char*)lds;
    F.MISC = (volatile LAS unsigned*)(F.lds + MISC_OFF);
    F.wave = __builtin_amdgcn_readfirstlane((int)threadIdx.x >> 6);
    F.G = gridDim.x; { const int bx = blockIdx.x; F.vcu = (F.G % 8 == 0) ? (bx % 8) * (F.G / 8) + bx / 8 : bx; }
    const KP kp0 = (KP)__builtin_amdgcn_kernarg_segment_ptr();
#define PP() ({ KP _k = kp0; asm volatile("" : "+s"(_k)); _k; })
    F.ws = kp0->ws; F.ctl = (gu32*)(kp0->ws + WS_CTL);
    for (int u = threadIdx.x; u < 128; u += 512) F.MISC[u] = 0u;
    __syncthreads();
    XcdBarrier bar; bar.bar = (unsigned*)(F.ctl + CW_BAR); bar.x = 0; bar.st = nullptr;
    if (!MK_PER_PHASE) bar = xcd_barrier_post((unsigned*)(F.ctl + CW_BAR), F.MISC + 8);
    const int lo = kp0->ph_lo, hi = kp0->ph_hi;
#define IN(k) (lo <= (k) && (k) < hi)
#define SEAM(k) do { if (!MK_PER_PHASE && IN((k) + 1)) xcd_barrier(bar); } while (0)

    if (IN(0)) { p0_prologue(F, PP()); SEAM(0); }
    for (int l = 0; l < DEPTH; ++l) {
        const int pb = 1 + NPH_LAYER * l;
        const float* mod = (const float*)(F.ws + WS_MOD);
        if (IN(pb + 0)) { phase_norm1(F, PP(), l); SEAM(pb + 0); }
        if (IN(pb + 1)) {
            if (F.vcu < 32) scan_item(F, F.vcu);
            for (int s = F.vcu + F.G; s < 32; s += F.G) scan_item(F, s);
            pg8::DenseSched S; S.init(NTOK, NQKV, DM, F.G, (int)blockIdx.x, F.ws + WS_H, F.ws + WS_WIN + (size_t)l * NQKV * DM * 2);
            EpiQKV E{(bf16_t*)(F.ws + WS_QKV), (const float*)(F.ws + WS_ROPE)};
            pg8::gemm_phase<EpiQKV, pg8::DenseSched, true>(F.lds, (const char*)(F.ws + WS_H), DM, S, E);
            SEAM(pb + 1);
        }
        if (IN(pb + 2)) { phase_attn(F, PP(), l); SEAM(pb + 2); }
        if (IN(pb + 3)) {
            pg8::DenseSched S; S.init(NTOK, DM, DM, F.G, (int)blockIdx.x, F.ws + WS_ATT, F.ws + WS_WOUT + (size_t)l * DM * DM * 2);
            EpiRes E{(bf16_t*)(F.ws + WS_X), mod + (size_t)l * 4 * 6144 + 2 * 1024};
            pg8::gemm_phase<EpiRes, pg8::DenseSched, true>(F.lds, (const char*)(F.ws + WS_ATT), DM, S, E);
            SEAM(pb + 3);
        }
        if (IN(pb + 4)) { phase_router(F, PP(), l); SEAM(pb + 4); }
        if (IN(pb + 5)) {
            MoeSched<true> S; moe_tables<true, false>(F, l, S); S.K = DM; S.A = (const char*)(F.ws + WS_H); S.Bt = (const char*)(F.ws + WS_WGU + (size_t)l * NEXP * 1024 * 1024 * 2); S.bstride = (size_t)1024 * 1024 * 2;
            EpiGU E{(bf16_t*)(F.ws + WS_ACT)};
            pg8::gemm_phase<EpiGU, MoeSched<true>, true>(F.lds, (const char*)(F.ws + WS_H), DM, S, E);
            SEAM(pb + 5);
        }
        if (IN(pb + 6)) {
            MoeSched<false> S; moe_tables<false, !MK_PER_PHASE>(F, l, S); S.K = DEXP; S.A = (const char*)(F.ws + WS_ACT); S.Bt = (const char*)(F.ws + WS_WD + (size_t)l * NEXP * 1024 * 512 * 2); S.bstride = (size_t)1024 * 512 * 2;
            EpiDown E{(bf16_t*)(F.ws + WS_YS), (const LAS int*)(F.lds + TENT_OFF), (const LAS float*)(F.lds + TAB_OFF + MAXU * 1024)};
            pg8::gemm_phase<EpiDown, MoeSched<false>, true>(F.lds, (const char*)(F.ws + WS_ACT), DEXP, S, E);
            SEAM(pb + 6);
        }
    }
    { KP q_ = PP(); if (q_->ph_lo <= NPHASES - 1 && NPHASES - 1 < q_->ph_hi) phase_norm1(F, q_, DEPTH); }
#undef IN
#undef SEAM
}

extern "C" void kernel_launch(void* const* d_in, const int* in_sizes, int n_in, void* d_out, int out_size, void* d_ws, size_t ws_size, hipStream_t stream) {
    static int grid = 0;
    if (grid == 0) {
        if (n_in != 24 || out_size != NTOK * DM || ws_size < WS_END) { fprintf(stderr, "kernel_launch: unexpected problem (n_in %d, out %d, ws %zu); nothing launched\n", n_in, out_size, ws_size); grid = -1; return; }
        int dev = 0, cus = 0, per_cu = 0;
        if (hipGetDevice(&dev) != hipSuccess || hipDeviceGetAttribute(&cus, hipDeviceAttributeMultiprocessorCount, dev) != hipSuccess) { grid = -1; return; }
        if (hipFuncSetAttribute((const void*)fwd_kernel, hipFuncAttributeMaxDynamicSharedMemorySize, LDS_BYTES) != hipSuccess) { fprintf(stderr, "kernel_launch: hipFuncSetAttribute failed\n"); grid = -1; return; }
        if (hipOccupancyMaxActiveBlocksPerMultiprocessor(&per_cu, (const void*)fwd_kernel, 512, LDS_BYTES) != hipSuccess || per_cu < 1) { fprintf(stderr, "kernel_launch: occupancy query reports %d blocks per CU\n", per_cu); }
        (void)hipGetLastError();
        grid = cus;
        if (grid > 256) grid = 256;
    }
    if (grid < 0) return;
    (void)hipMemsetAsync((char*)d_ws + WS_CTL, 0, CTL_ZERO_BYTES, stream);
    Params p{};
    p.x = (const float*)d_in[0]; p.c = (const float*)d_in[1]; p.pos = (const int*)d_in[2]; p.w_ada = (const float*)d_in[3]; p.b_ada = (const float*)d_in[4]; p.g_mix = (const float*)d_in[5];
    p.w_in = (const float*)d_in[6]; p.b_forget = (const float*)d_in[7]; p.lq1 = (const float*)d_in[8]; p.lk1 = (const float*)d_in[9]; p.lq2 = (const float*)d_in[10]; p.lk2 = (const float*)d_in[11];
    p.g_subln = (const float*)d_in[12]; p.g_fox = (const float*)d_in[13]; p.w_out = (const float*)d_in[14]; p.g_ffn = (const float*)d_in[15]; p.wrg = (const float*)d_in[16]; p.brg = (const float*)d_in[17];
    p.wre = (const float*)d_in[18]; p.bre = (const float*)d_in[19]; p.wg = (const float*)d_in[20]; p.wu = (const float*)d_in[21]; p.wd = (const float*)d_in[22]; p.g_final = (const float*)d_in[23];
    p.out = (float*)d_out; p.ws = (unsigned char*)d_ws;
#if MK_PER_PHASE
    for (int ph = 0; ph < NPHASES; ++ph) { p.ph_lo = ph; p.ph_hi = ph + 1; hipLaunchKernelGGL(fwd_kernel, dim3(grid), dim3(512), LDS_BYTES, stream, p);
    }
#else
    p.ph_lo = 0; p.ph_hi = NPHASES;
    hipLaunchKernelGGL(fwd_kernel, dim3(grid), dim3(512), LDS_BYTES, stream, p);
#endif
    const hipError_t le = hipPeekAtLastError();
    if (le != hipSuccess) fprintf(stderr, "kernel_launch: launch failed: %s\n", hipGetErrorName(le));
}
```
